# Optimizing an MI355X kernel written in HIP

```python
import math
import jax
import jax.numpy as jnp
from jax import lax
import numpy as np

D_MODEL = 1024
BATCH = 4
SEQ = 8192
DEPTH = 4

GRID_W = 64
CTX_LEN = 256
N_MIXERS = 3
N_GDN_LAYERS = (DEPTH + 2) // 3
N_LRU_LAYERS = (DEPTH + 1) // 3
N_HG_LAYERS = DEPTH // 3
EPS = 1e-6
CONV_W = 4
CONV_PAD = (2, 1)
FFN_HIDDEN = -(-(8 * D_MODEL) // (3 * 256)) * 256

GDN_HEADS = 8
GDN_DK = 128
GDN_DV = 128
GDN_CHUNK = 64
GDN_QKV = GDN_HEADS * (2 * GDN_DK + GDN_DV)
GDN_Z = GDN_HEADS * GDN_DV
GDN_IN = GDN_QKV + GDN_Z + 4 * GDN_HEADS

LRU_WIDTH = D_MODEL
LRU_BLOCKS = 8
LRU_BW = LRU_WIDTH // LRU_BLOCKS
LRU_C = 8.0

HG_HEADS = 8
HG_DK = 128
HG_DV = D_MODEL // HG_HEADS
HG_CHUNK = 64
HG_QK = HG_HEADS * HG_DK
HG_V = HG_HEADS * HG_DV
HG_IN = 3 * HG_QK + 2 * HG_V

kernel_name = 'hybrid_gdn_rglru_hgrn2_flow_block'


def rmsnorm(x, w):
    xf = x.astype(jnp.float32)
    y = xf * lax.rsqrt(jnp.mean(xf * xf, axis=-1, keepdims=True) + EPS)
    return (y * w.astype(jnp.float32)).astype(x.dtype)


def l2norm(x):
    xf = x.astype(jnp.float32)
    return xf * lax.rsqrt(jnp.sum(xf * xf, axis=-1, keepdims=True) + EPS)


def modulate(h, shift, scale):
    return h * (1.0 + scale) + shift


def short_conv(x, w, b=None):
    L = x.shape[1]
    xp = jnp.pad(x, ((0, 0), CONV_PAD, (0, 0)))
    y = xp[:, 0:L] * w[0]
    for j in range(1, CONV_W):
        y = y + xp[:, j:j + L] * w[j]
    return y if b is None else y + b


def to_heads(t, n_heads):
    bsz, L, _ = t.shape
    return t.reshape(bsz, L, n_heads, -1).transpose(0, 2, 1, 3)


def flip(t, rev, axis):
    return jnp.flip(t, axis=axis) if rev else t


def to_scan_order(h, col):
    if not col:
        return h
    bsz, L, d = h.shape
    rows = L // GRID_W
    return h.reshape(bsz, rows, GRID_W, d).transpose(0, 2, 1, 3).reshape(bsz, L, d)


def from_scan_order(h, col):
    if not col:
        return h
    bsz, L, d = h.shape
    rows = L // GRID_W
    return h.reshape(bsz, GRID_W, rows, d).transpose(0, 2, 1, 3).reshape(bsz, L, d)


def gated_head_norm(o, z, w):
    bsz, nh, L, dv = o.shape
    y = rmsnorm(o.transpose(0, 2, 1, 3), w) * jax.nn.silu(z.reshape(bsz, L, nh, dv).astype(jnp.float32))
    return y.reshape(bsz, L, nh * dv).astype(z.dtype)


def swiglu(h, w1, w3, w2):
    return (jax.nn.silu(h @ w1) * (h @ w3)) @ w2


def gated_delta_rule(q, k, v, g, beta, s0):
    bsz, nh, L, dk = q.shape
    dv = v.shape[-1]
    C = GDN_CHUNK
    n = L // C
    q, k = (t.astype(jnp.float32).reshape(bsz, nh, n, C, dk) for t in (q, k))
    v = v.astype(jnp.float32).reshape(bsz, nh, n, C, dv)
    g, beta = (t.astype(jnp.float32).reshape(bsz, nh, n, C) for t in (g, beta))
    gcum = jnp.cumsum(g, axis=-1)
    incl = jnp.tril(jnp.ones((C, C), dtype=bool))
    strict = jnp.tril(jnp.ones((C, C), dtype=bool), -1)
    decay = jnp.exp(jnp.where(incl, gcum[..., :, None] - gcum[..., None, :], -jnp.inf))
    kb = k * beta[..., None]
    lmat = jnp.where(strict, jnp.einsum('bhnid,bhnjd->bhnij', kb, k) * decay, 0.0)
    eye = jnp.eye(C, dtype=jnp.float32)
    t_inv = lax.linalg.triangular_solve(eye + lmat, jnp.broadcast_to(eye, lmat.shape),
                                        left_side=True, lower=True, unit_diagonal=True)
    u = t_inv @ (v * beta[..., None])
    w = t_inv @ (kb * jnp.exp(gcum)[..., None])
    a_qk = jnp.einsum('bhnid,bhnjd->bhnij', q, k) * decay
    glast = gcum[..., -1]
    q_dec = q * jnp.exp(gcum)[..., None]
    k_dec = k * jnp.exp(glast[..., None] - gcum)[..., None]
    xs = tuple(jnp.moveaxis(t, 2, 0) for t in (q_dec, k_dec, u, w, a_qk, jnp.exp(glast)))

    def step(s, inp):
        qd, kd, uc, wc, aqk, dl = inp
        v_new = uc - wc @ s
        o = qd @ s + aqk @ v_new
        s = s * dl[..., None, None] + jnp.swapaxes(kd, -1, -2) @ v_new
        return s, o

    s_fin, o = lax.scan(step, s0, xs)
    return jnp.moveaxis(o, 0, 2).reshape(bsz, nh, L, dv), s_fin


def gdn_project(h, w_in, conv_w, a_log, dt_bias):
    bsz, L, _ = h.shape
    p = h @ w_in
    qkv = jax.nn.silu(short_conv(p[..., :GDN_QKV], conv_w))
    z = p[..., GDN_QKV:GDN_QKV + GDN_Z]
    ab = p[..., GDN_QKV + GDN_Z:].astype(jnp.float32).reshape(bsz, L, 2, 2, GDN_HEADS)
    hk = GDN_HEADS * GDN_DK
    q = l2norm(to_heads(qkv[..., :hk], GDN_HEADS)) * (GDN_DK ** -0.5)
    k = l2norm(to_heads(qkv[..., hk:2 * hk], GDN_HEADS))
    v = to_heads(qkv[..., 2 * hk:], GDN_HEADS).astype(jnp.float32)
    g = -jnp.exp(a_log.astype(jnp.float32)) * jax.nn.softplus(ab[:, :, 0] + dt_bias.astype(jnp.float32))
    beta = jax.nn.sigmoid(ab[:, :, 1])
    return q, k, v, g.transpose(2, 0, 3, 1), beta.transpose(2, 0, 3, 1), z


def gdn_mixer(hc, hl, w_in, conv_w, a_log, dt_bias, norm_w, w_out, need_ctx):
    qc, kc, vc, gam_c, bet_c, zc = gdn_project(hc, w_in, conv_w, a_log, dt_bias)
    ql, kl, vl, gam_l, bet_l, zl = gdn_project(hl, w_in, conv_w, a_log, dt_bias)
    s0 = jnp.zeros((hc.shape[0], GDN_HEADS, GDN_DK, GDN_DV), jnp.float32)
    o_c, o_l = [], []
    for d in range(2):
        rev = d == 1
        oc, s_ctx = gated_delta_rule(*[flip(t, rev, 2) for t in (qc, kc, vc, gam_c[d], bet_c[d])], s0)
        ol, _ = gated_delta_rule(*[flip(t, rev, 2) for t in (ql, kl, vl, gam_l[d], bet_l[d])], s_ctx)
        o_c.append(flip(oc, rev, 2))
        o_l.append(flip(ol, rev, 2))
    out_l = gated_head_norm(o_l[0] + o_l[1], zl, norm_w) @ w_out
    out_c = gated_head_norm(o_c[0] + o_c[1], zc, norm_w) @ w_out if need_ctx else None
    return out_c, out_l


def linear_scan(log_a, b, h0):
    def combine(e1, e2):
        la1, b1 = e1
        la2, b2 = e2
        return la1 + la2, jnp.exp(la2) * b1 + b2
    la_cum, h = lax.associative_scan(combine, (log_a, b), axis=1)
    h = h + jnp.exp(la_cum) * h0[:, None, :]
    return h, h[:, -1]


def lru_gates(xr, w_r, b_r, w_i, b_i, lam):
    bsz, L, _ = xr.shape
    xf = xr.astype(jnp.float32)
    xb = xf.reshape(bsz, L, LRU_BLOCKS, LRU_BW)
    r = jax.nn.sigmoid(jnp.einsum('blgi,gij->blgj', xb, w_r.astype(jnp.float32)).reshape(bsz, L, LRU_WIDTH) + b_r)
    ig = jax.nn.sigmoid(jnp.einsum('blgi,gij->blgj', xb, w_i.astype(jnp.float32)).reshape(bsz, L, LRU_WIDTH) + b_i)
    log_a = -LRU_C * r * jax.nn.softplus(-lam.astype(jnp.float32))
    b = jnp.sqrt(-jnp.expm1(2.0 * log_a)) * (ig * xf)
    return log_a, b


def rglru_mixer(hc, hl, w_in, conv_w, conv_b, w_r, b_r, w_i, b_i, lam, w_out, need_ctx):
    def branches(h):
        p = h @ w_in
        return jax.nn.gelu(p[..., :LRU_WIDTH]), short_conv(p[..., LRU_WIDTH:], conv_w, conv_b)
    gate_c, xc = branches(hc)
    gate_l, xl = branches(hl)
    h0 = jnp.zeros((hc.shape[0], LRU_WIDTH), jnp.float32)
    h_c, h_l = [], []
    for d in range(2):
        rev = d == 1
        la, b = lru_gates(xc, w_r[d], b_r[d], w_i[d], b_i[d], lam[d])
        yc, s_ctx = linear_scan(flip(la, rev, 1), flip(b, rev, 1), h0)
        la, b = lru_gates(xl, w_r[d], b_r[d], w_i[d], b_i[d], lam[d])
        yl, _ = linear_scan(flip(la, rev, 1), flip(b, rev, 1), s_ctx)
        h_c.append(flip(yc, rev, 1))
        h_l.append(flip(yl, rev, 1))
    out_l = (gate_l * (h_l[0] + h_l[1]).astype(hl.dtype)) @ w_out
    out_c = (gate_c * (h_c[0] + h_c[1]).astype(hc.dtype)) @ w_out if need_ctx else None
    return out_c, out_l


def gla_chunk(q, k, log_f, v, s0):
    bsz, nh, L, dk = q.shape
    dv = v.shape[-1]
    C = HG_CHUNK
    n = L // C
    q, k, log_f = (t.reshape(bsz, nh, n, C, dk) for t in (q, k, log_f))
    v = v.reshape(bsz, nh, n, C, dv)
    gcum = jnp.cumsum(log_f, axis=-2)
    ref = gcum[..., C // 2:C // 2 + 1, :]
    incl = jnp.tril(jnp.ones((C, C), dtype=bool))
    scores = jnp.einsum('bhnid,bhnjd->bhnij', q * jnp.exp(gcum - ref), k * jnp.exp(ref - gcum))
    o_intra = jnp.where(incl, scores, 0.0) @ v
    glast = gcum[..., -1, :]
    upd = jnp.einsum('bhncd,bhnce->bhnde', k * jnp.exp(glast[..., None, :] - gcum), v)

    def step(s, inp):
        dl, u = inp
        return s * dl[..., :, None] + u, s

    s_fin, s_prev = lax.scan(step, s0, (jnp.moveaxis(jnp.exp(glast), 2, 0), jnp.moveaxis(upd, 2, 0)))
    o_inter = jnp.einsum('bhncd,bhnde->bhnce', q * jnp.exp(gcum), jnp.moveaxis(s_prev, 0, 2))
    return (o_intra + o_inter).reshape(bsz, nh, L, dv), s_fin


def hgrn2_project(h, w_in, lb):
    p = h @ w_in
    q = to_heads(jax.nn.silu(p[..., :HG_QK]), HG_HEADS).astype(jnp.float32)
    v = to_heads(p[..., 3 * HG_QK:3 * HG_QK + HG_V], HG_HEADS).astype(jnp.float32)
    z = p[..., 3 * HG_QK + HG_V:]
    keys, logfs = [], []
    for d in range(2):
        f = lb + (1.0 - lb) * jax.nn.sigmoid(p[..., (1 + d) * HG_QK:(2 + d) * HG_QK].astype(jnp.float32))
        keys.append(to_heads(1.0 - f, HG_HEADS))
        logfs.append(to_heads(jnp.log(f), HG_HEADS))
    return q, v, z, keys, logfs


def hgrn2_mixer(hc, hl, w_in, lb, norm_w, w_out, need_ctx):
    qc, vc, zc, kc, fc = hgrn2_project(hc, w_in, lb)
    ql, vl, zl, kl, fl = hgrn2_project(hl, w_in, lb)
    s0 = jnp.zeros((hc.shape[0], HG_HEADS, HG_DK, HG_DV), jnp.float32)
    o_c, o_l = [], []
    for d in range(2):
        rev = d == 1
        oc, s_ctx = gla_chunk(*[flip(t, rev, 2) for t in (qc, kc[d], fc[d], vc)], s0)
        ol, _ = gla_chunk(*[flip(t, rev, 2) for t in (ql, kl[d], fl[d], vl)], s_ctx)
        o_c.append(flip(oc, rev, 2))
        o_l.append(flip(ol, rev, 2))
    out_l = gated_head_norm(o_l[0] + o_l[1], zl, norm_w) @ w_out
    out_c = gated_head_norm(o_c[0] + o_c[1], zc, norm_w) @ w_out if need_ctx else None
    return out_c, out_l


def setup_inputs(seed: int = 0) -> dict:
    key = jax.random.key(seed)
    keys = iter(jax.random.split(key, 48))
    f32 = jnp.float32

    def normal(shape, scale=1.0):
        return scale * jax.random.normal(next(keys), shape, f32)

    def dense(shape, fan_in, scale=1.0):
        return normal(shape, scale * fan_in ** -0.5)

    def gain(shape):
        return 1.0 + normal(shape, 0.05)

    def uniform(shape, lo, hi):
        return jax.random.uniform(next(keys), shape, f32, lo, hi)

    D = D_MODEL
    dt = jnp.exp(uniform((N_GDN_LAYERS, 2, GDN_HEADS), math.log(1e-3), math.log(1e-1)))
    a0 = uniform((N_LRU_LAYERS, 2, LRU_WIDTH), 0.9, 0.999)
    return {
        'x': normal((BATCH, SEQ, D)),
        'c': normal((BATCH, D)),
        'ctx': normal((BATCH, CTX_LEN, D)),
        'c_ctx': normal((D,)),
        'ada_w': dense((DEPTH, D, 6 * D), D, 0.5),
        'ada_b': normal((DEPTH, 6 * D), 0.01),
        'norm_mix': gain((DEPTH, D)),
        'norm_ffn': gain((DEPTH, D)),
        'norm_final': gain((D,)),
        'ffn_w1': dense((DEPTH, D, FFN_HIDDEN), D),
        'ffn_w3': dense((DEPTH, D, FFN_HIDDEN), D),
        'ffn_w2': dense((DEPTH, FFN_HIDDEN, D), FFN_HIDDEN),
        'gdn_w_in': dense((N_GDN_LAYERS, D, GDN_IN), D),
        'gdn_conv': dense((N_GDN_LAYERS, CONV_W, GDN_QKV), CONV_W),
        'gdn_a_log': jnp.log(uniform((N_GDN_LAYERS, 2, GDN_HEADS), 1.0, 16.0)),
        'gdn_dt_bias': dt + jnp.log(-jnp.expm1(-dt)),
        'gdn_norm': gain((N_GDN_LAYERS, GDN_DV)),
        'gdn_w_out': dense((N_GDN_LAYERS, GDN_Z, D), GDN_Z),
        'lru_w_in': dense((N_LRU_LAYERS, D, 2 * LRU_WIDTH), D),
        'lru_conv_w': dense((N_LRU_LAYERS, CONV_W, LRU_WIDTH), CONV_W),
        'lru_conv_b': normal((N_LRU_LAYERS, LRU_WIDTH), 0.01),
        'lru_w_r': dense((N_LRU_LAYERS, 2, LRU_BLOCKS, LRU_BW, LRU_BW), LRU_BW),
        'lru_b_r': normal((N_LRU_LAYERS, 2, LRU_WIDTH), 0.01),
        'lru_w_i': dense((N_LRU_LAYERS, 2, LRU_BLOCKS, LRU_BW, LRU_BW), LRU_BW),
        'lru_b_i': normal((N_LRU_LAYERS, 2, LRU_WIDTH), 0.01),
        'lru_lambda': jnp.log(a0) - jnp.log1p(-a0),
        'lru_w_out': dense((N_LRU_LAYERS, LRU_WIDTH, D), LRU_WIDTH),
        'hg_w_in': dense((N_HG_LAYERS, D, HG_IN), D),
        'hg_lb_logits': normal((DEPTH, HG_QK), 0.1),
        'hg_norm': gain((N_HG_LAYERS, HG_DV)),
        'hg_w_out': dense((N_HG_LAYERS, HG_V, D), HG_V),
    }


def reference(x, c, ctx, c_ctx, ada_w, ada_b, norm_mix, norm_ffn, norm_final,
              ffn_w1, ffn_w3, ffn_w2,
              gdn_w_in, gdn_conv, gdn_a_log, gdn_dt_bias, gdn_norm, gdn_w_out,
              lru_w_in, lru_conv_w, lru_conv_b, lru_w_r, lru_b_r, lru_w_i, lru_b_i,
              lru_lambda, lru_w_out,
              hg_w_in, hg_lb_logits, hg_norm, hg_w_out):
    lb_p = jax.nn.softmax(hg_lb_logits.astype(jnp.float32), axis=0)
    lower_bounds = jnp.cumsum(lb_p, axis=0) - lb_p[0]
    silu_c = jax.nn.silu(c)[:, None, :]
    silu_cc = jax.nn.silu(c_ctx)[None, None, :]
    xl, xc = x, ctx
    for i in range(DEPTH):
        last = i == DEPTH - 1
        mod_l = jnp.split(silu_c @ ada_w[i] + ada_b[i], 6, axis=-1)
        mod_c = jnp.split(silu_cc @ ada_w[i] + ada_b[i], 6, axis=-1)
        col = i % 2 == 1
        hl = to_scan_order(modulate(rmsnorm(xl, norm_mix[i]), mod_l[0], mod_l[1]), col)
        hc = modulate(rmsnorm(xc, norm_mix[i]), mod_c[0], mod_c[1])
        kind, j = i % N_MIXERS, i // N_MIXERS
        if kind == 0:
            oc, ol = gdn_mixer(hc, hl, gdn_w_in[j], gdn_conv[j], gdn_a_log[j], gdn_dt_bias[j],
                               gdn_norm[j], gdn_w_out[j], not last)
        elif kind == 1:
            oc, ol = rglru_mixer(hc, hl, lru_w_in[j], lru_conv_w[j], lru_conv_b[j], lru_w_r[j],
                                 lru_b_r[j], lru_w_i[j], lru_b_i[j], lru_lambda[j], lru_w_out[j],
                                 not last)
        else:
            oc, ol = hgrn2_mixer(hc, hl, hg_w_in[j], lower_bounds[i], hg_norm[j], hg_w_out[j],
                                 not last)
        xl = xl + mod_l[2] * from_scan_order(ol, col)
        xl = xl + mod_l[5] * swiglu(modulate(rmsnorm(xl, norm_ffn[i]), mod_l[3], mod_l[4]),
                                    ffn_w1[i], ffn_w3[i], ffn_w2[i])
        if not last:
            xc = xc + mod_c[2] * oc
            xc = xc + mod_c[5] * swiglu(modulate(rmsnorm(xc, norm_ffn[i]), mod_c[3], mod_c[4]),
                                        ffn_w1[i], ffn_w3[i], ffn_w2[i])
    return rmsnorm(xl, norm_final)
```

```cpp
#include <hip/hip_runtime.h>
#include <hip/hip_cooperative_groups.h>
#include <cstdio>
#include <cstdint>
namespace cg = cooperative_groups;

#define DI __device__ __forceinline__
typedef __attribute__((ext_vector_type(8))) short bf16x8;
typedef __attribute__((ext_vector_type(16))) float f32x16;
typedef unsigned short bfr;
typedef __attribute__((ext_vector_type(4))) float f32x4_t;
#define MFMA32(a, b, c) __builtin_amdgcn_mfma_f32_32x32x16_bf16((a), (b), (c), 0, 0, 0)

#ifndef MULTI_LAUNCH
#define MULTI_LAUNCH 0
#endif

constexpr int DM = 1024;
constexpr int NB = 4;
constexpr int SEQ = 8192;
constexpr int CTX = 256;
constexpr int LTOK = CTX + SEQ;
constexpr int T = NB * LTOK;
constexpr int NCH = LTOK / 64;
constexpr int FFH = 2816;
constexpr int NTHR = 512;
constexpr int GDN_IN = 4128;
constexpr int HG_IN = 5120;
constexpr size_t UB = (size_t)T * 1024 * 2;
constexpr int LDS_BYTES = 147456 + 512;

constexpr size_t OFF_SMALL = 7 * UB;
constexpr size_t OFF_AB  = OFF_SMALL;
constexpr size_t OFF_GC  = OFF_AB + (size_t)T * 32 * 4;
constexpr size_t OFF_BT  = OFF_GC + (size_t)64 * LTOK * 4;
constexpr size_t OFF_XC  = OFF_BT + (size_t)64 * LTOK * 4;
constexpr size_t OFF_MOD = OFF_XC + (size_t)NB * CTX * DM * 4;
constexpr size_t OFF_WB  = OFF_MOD + (size_t)4 * 5 * 6144 * 4;
constexpr size_t WB_W1 = 0, WB_W3 = (size_t)FFH * 1024, WB_W2 = 2 * (size_t)FFH * 1024, WB_IN = 3 * (size_t)FFH * 1024;
constexpr size_t WB_OUT = WB_IN + (size_t)5120 * 1024, WB_GATE = WB_OUT + (size_t)1024 * 1024, WB_END = WB_GATE + (size_t)32 * 128 * 128;
constexpr size_t OFF_BAR = OFF_WB + WB_END * 2;
constexpr size_t BAR_BYTES = 3456 * 4;
constexpr size_t WS_NEED = OFF_BAR + BAR_BYTES;

struct Params {
  const float *x, *c, *ctx, *c_ctx, *ada_w, *ada_b, *norm_mix, *norm_ffn, *norm_final;
  const float *ffn_w1, *ffn_w3, *ffn_w2;
  const float *gdn_w_in, *gdn_conv, *gdn_a_log, *gdn_dt_bias, *gdn_norm, *gdn_w_out;
  const float *lru_w_in, *lru_conv_w, *lru_conv_b, *lru_w_r, *lru_b_r, *lru_w_i, *lru_b_i, *lru_lambda, *lru_w_out;
  const float *hg_w_in, *hg_lb_logits, *hg_norm, *hg_w_out;
  float* out;
  char* ws;
  int ph_lo, ph_hi;
};

typedef __attribute__((ext_vector_type(2))) float f2_t;
typedef __attribute__((ext_vector_type(2))) __bf16 bf2_t;
DI bfr f2bf(float x) { __bf16 r = (__bf16)x; return __builtin_bit_cast(bfr, r); }
DI float bf2f(bfr v) { return __uint_as_float(((unsigned)v) << 16); }
DI unsigned pack2(float a, float b) { f2_t v = {a, b}; bf2_t r = __builtin_convertvector(v, bf2_t); return __builtin_bit_cast(unsigned, r); }
DI uint2 pack4(float a, float b, float c, float d) { uint2 u; u.x = pack2(a, b); u.y = pack2(c, d); return u; }
DI float lo2f(unsigned u) { return __uint_as_float(u << 16); }
DI float hi2f(unsigned u) { return __uint_as_float(u & 0xffff0000u); }
DI float sigmoidf_(float x) { return __builtin_amdgcn_rcpf(1.f + __expf(-x)); }
DI float siluf_(float x) { return x * __builtin_amdgcn_rcpf(1.f + __expf(-x)); }
DI float softplusf_(float x) { return x > 20.f ? x : log1pf(expf(x)); }
DI float geluf_(float x) { float u = 0.7978845608028654f * (x + 0.044715f * x * x * x); float t = 1.f - 2.f * __builtin_amdgcn_rcpf(1.f + __expf(2.f * u)); return 0.5f * x * (1.f + t); }
DI int tid_() { int t = threadIdx.x; asm volatile("" : "+v"(t)); return t; }
DI int bid_() { int t = blockIdx.x; asm volatile("" : "+s"(t)); return t; }
#define LDS_BARRIER() { asm volatile("s_waitcnt lgkmcnt(0)" ::: "memory"); __builtin_amdgcn_s_barrier(); asm volatile("" ::: "memory"); }
DI int crow(int reg, int hh) { return (reg & 3) + 8 * (reg >> 2) + 4 * hh; }

DI void xrow_ptr(const Params& p, int r, bool colmaj, bool first, const float*& xin, float*& xout, int& modrow) {
  int b = r / LTOK, q = r - b * LTOK;
  if (q < CTX) {
    size_t o = ((size_t)b * CTX + q) * DM;
    xout = (float*)(p.ws + OFF_XC) + o;
    xin = first ? p.ctx + o : xout;
    modrow = 4;
  } else {
    int s = q - CTX;
    int orig = colmaj ? ((s & 127) * 64 + (s >> 7)) : s;
    size_t o = ((size_t)b * SEQ + orig) * DM;
    xout = p.out + o;
    xin = first ? p.x + o : xout;
    modrow = b;
  }
}

DI void phase_mod(const Params& p, char* lds) {
  float* sc = (float*)lds;
  float* red = sc + 5 * 1024;
  const int tid = tid_();
  for (int i = tid; i < 5 * 1024; i += NTHR) {
    int r = i >> 10, k = i & 1023;
    float v = (r < 4) ? p.c[r * 1024 + k] : p.c_ctx[k];
    sc[i] = siluf_(v);
  }
  __syncthreads();
  float* MOD = (float*)(p.ws + OFF_MOD);
  const int col = tid & 63, kq = tid >> 6;
  for (int item = bid_(); item < 4 * 96; item += gridDim.x) {
    int l = item / 96, n = (item % 96) * 64 + col;
    const float* w = p.ada_w + (size_t)l * 1024 * 6144 + n;
    float a0 = 0, a1 = 0, a2 = 0, a3 = 0, a4 = 0;
#pragma unroll 8
    for (int k = kq * 128; k < kq * 128 + 128; ++k) {
      float wv = w[(size_t)k * 6144];
      a0 += sc[k] * wv; a1 += sc[1024 + k] * wv; a2 += sc[2048 + k] * wv; a3 += sc[3072 + k] * wv; a4 += sc[4096 + k] * wv;
    }
    red[(kq * 5 + 0) * 64 + col] = a0; red[(kq * 5 + 1) * 64 + col] = a1; red[(kq * 5 + 2) * 64 + col] = a2;
    red[(kq * 5 + 3) * 64 + col] = a3; red[(kq * 5 + 4) * 64 + col] = a4;
    __syncthreads();
    if (tid < 320) {
      int r = tid >> 6, c = tid & 63;
      float s = 0;
      for (int q = 0; q < 8; ++q) s += red[(q * 5 + r) * 64 + c];
      int nn = (item % 96) * 64 + c;
      MOD[((size_t)l * 5 + r) * 6144 + nn] = s + p.ada_b[l * 6144 + nn];
    }
    __syncthreads();
  }
}

DI void phase_norm(const Params& p, int layer, const float* nw, int shi, int sci, bool colmaj, bool first) {
  const int lane = tid_() & 63, w = tid_() >> 6;
  bfr* H = (bfr*)p.ws;
  const float* MOD = (const float*)(p.ws + OFF_MOD) + (size_t)layer * 5 * 6144;
  const int stride = gridDim.x * 8;
  float4 wv[4];
#pragma unroll
  for (int i = 0; i < 4; ++i) wv[i] = *(const float4*)(nw + lane * 4 + 256 * i);
  for (int r0 = bid_() * 8 + w; r0 < T; r0 += 2 * stride) {
    float4 v[2][4]; int mr[2]; float ss[2];
#pragma unroll
    for (int k = 0; k < 2; ++k) {
      const int r = r0 + k * stride < T ? r0 + k * stride : r0;
      const float* xin; float* xout;
      xrow_ptr(p, r, colmaj, first, xin, xout, mr[k]);
#pragma unroll
      for (int i = 0; i < 4; ++i) v[k][i] = *(const float4*)(xin + lane * 4 + 256 * i);
    }
#pragma unroll
    for (int k = 0; k < 2; ++k) {
      float a = 0;
#pragma unroll
      for (int i = 0; i < 4; ++i) a += v[k][i].x * v[k][i].x + v[k][i].y * v[k][i].y + v[k][i].z * v[k][i].z + v[k][i].w * v[k][i].w;
#pragma unroll
      for (int o = 32; o > 0; o >>= 1) a += __shfl_xor(a, o);
      ss[k] = rsqrtf(a * (1.f / 1024.f) + 1e-6f);
    }
#pragma unroll
    for (int k = 0; k < 2; ++k) {
      const int r = r0 + k * stride;
      if (r < T) {
        const float* sh = MOD + mr[k] * 6144 + shi * 1024;
        const float* scl = MOD + mr[k] * 6144 + sci * 1024;
#pragma unroll
        for (int i = 0; i < 4; ++i) {
          const int kk = lane * 4 + 256 * i;
          const float4 s4 = *(const float4*)(sh + kk), c4 = *(const float4*)(scl + kk);
          const float rstd = ss[k];
          *(uint2*)(H + (size_t)r * 1024 + kk) = pack4(v[k][i].x * rstd * wv[i].x * (1.f + c4.x) + s4.x, v[k][i].y * rstd * wv[i].y * (1.f + c4.y) + s4.y,
                                                     v[k][i].z * rstd * wv[i].z * (1.f + c4.z) + s4.z, v[k][i].w * rstd * wv[i].w * (1.f + c4.w) + s4.w);
        }
      }
    }
  }
}

DI void wprep_mat(const float* src, int K, int N, bfr* dst, int& off, float* tl, int vb, int VG) {
  const int tid = tid_();
  const int tk = K >> 6, tn = (N + 63) >> 6, ntile = tk * tn;
  const int G = VG;
  int start = (vb + G - (off % G)) % G;
  off += ntile;
  const int kr = tid >> 4, n4 = (tid & 15) * 4;
  float4 v0 = make_float4(0, 0, 0, 0), v1 = v0;
#define WP_LOAD(t_)                                                                     \
  {                                                                                     \
    const int k0_ = ((t_) % tk) * 64, n0_ = ((t_) / tk) * 64;                           \
    v0 = make_float4(0, 0, 0, 0); v1 = v0;                                              \
    if (n0_ + n4 < N) { v0 = *(const float4*)(src + (size_t)(k0_ + kr) * N + n0_ + n4); v1 = *(const float4*)(src + (size_t)(k0_ + kr + 32) * N + n0_ + n4); } \
  }
  if (start < ntile) WP_LOAD(start);
  for (int t = start; t < ntile; t += G) {
    const int kt = t % tk, nt = t / tk;
    const int k0 = kt * 64, n0 = nt * 64;
    {
      float* d = tl + kr * 65 + n4;
      d[0] = v0.x; d[1] = v0.y; d[2] = v0.z; d[3] = v0.w;
      d += 32 * 65;
      d[0] = v1.x; d[1] = v1.y; d[2] = v1.z; d[3] = v1.w;
    }
    if (t + G < ntile) WP_LOAD(t + G);
    LDS_BARRIER();
    {
      int n = tid >> 3, k8 = (tid & 7) * 8;
      if (n0 + n < N) {
        float f[8];
#pragma unroll
        for (int e = 0; e < 8; ++e) f[e] = tl[(k8 + e) * 65 + n];
        *(uint4*)(dst + (size_t)(n0 + n) * K + k0 + k8) = make_uint4(pack2(f[0], f[1]), pack2(f[2], f[3]), pack2(f[4], f[5]), pack2(f[6], f[7]));
      }
    }
    LDS_BARRIER();
  }
#undef WP_LOAD
}

DI void phase_wprep(const Params& p, int layer, char* lds, int mask, int vb, int VG) {
  if (vb < 0) return;
  float* tl = (float*)lds;
  bfr* WB = (bfr*)(p.ws + OFF_WB);
  const int kind = layer % 3, jl = layer / 3;
  int off = 0;
  if (mask & 1) {
    wprep_mat(p.ffn_w1 + (size_t)layer * 1024 * FFH, 1024, FFH, WB + WB_W1, off, tl, vb, VG);
    wprep_mat(p.ffn_w3 + (size_t)layer * 1024 * FFH, 1024, FFH, WB + WB_W3, off, tl, vb, VG);
  }
  if (mask & 2) wprep_mat(p.ffn_w2 + (size_t)layer * FFH * 1024, FFH, 1024, WB + WB_W2, off, tl, vb, VG);
  if (mask & 4) {
    if (kind == 0) {
      wprep_mat(p.gdn_w_in + (size_t)jl * 1024 * GDN_IN, 1024, GDN_IN, WB + WB_IN, off, tl, vb, VG);
      wprep_mat(p.gdn_w_out + (size_t)jl * 1024 * 1024, 1024, 1024, WB + WB_OUT, off, tl, vb, VG);
    } else if (kind == 1) {
      wprep_mat(p.lru_w_in + (size_t)jl * 1024 * 2048, 1024, 2048, WB + WB_IN, off, tl, vb, VG);
      wprep_mat(p.lru_w_out + (size_t)jl * 1024 * 1024, 1024, 1024, WB + WB_OUT, off, tl, vb, VG);
#pragma unroll 1
      for (int m = 0; m < 32; ++m) {
        int d = m >> 4, which = (m >> 3) & 1, g = m & 7;
        const float* src = (which ? p.lru_w_i : p.lru_w_r) + ((size_t)(jl * 2 + d) * 8 + g) * 128 * 128;
        wprep_mat(src, 128, 128, WB + WB_GATE + (size_t)m * 128 * 128, off, tl, vb, VG);
      }
    } else {
      wprep_mat(p.hg_w_in + (size_t)jl * 1024 * HG_IN, 1024, HG_IN, WB + WB_IN, off, tl, vb, VG);
      wprep_mat(p.hg_w_out + (size_t)jl * 1024 * 1024, 1024, 1024, WB + WB_OUT, off, tl, vb, VG);
    }
  }
}

template <int BM, class Epi>
DI void gemm_phase(const bfr* A, int lda, int K, int NT, const Epi& epi, char* lds, int mt_off = 0, int MT = T / BM) {
  constexpr int MI = BM / 128;
  constexpr int AI = BM / 64;
  constexpr int LS = 72;
  constexpr int LA_ = BM * LS;
  constexpr int LB_ = 128 * LS;
  bfr* sA0 = (bfr*)lds; bfr* sB0 = sA0 + LA_; bfr* sA1 = sB0 + LB_; bfr* sB1 = sA1 + LA_;
  float* stg = (float*)lds;
  const int tid = tid_(), lane = tid & 63, w = tid >> 6, wm = w >> 1, wn = w & 1, l31 = lane & 31, hh = lane >> 5;
  const int KT = K / 64;
  const int crow_ = tid >> 3, kc = (tid & 7) * 8;
  const int G = gridDim.x, bid = bid_();
  const int ntiles = MT * NT;
  int ctile = (bid & 7) * (G >> 3) + (bid >> 3);
  if (ctile >= ntiles) return;
  int ltile = ctile;
  const bfr *lap, *lb0, *lb1;
  bool lvalid = true;
#define SETLOAD(t_)                                                                      \
  {                                                                                      \
    const int band_ = (t_) / (4 * NT), within_ = (t_) - band_ * 4 * NT;                  \
    const int nt_ = within_ >> 2, mt_ = band_ * 4 + (within_ & 3);                       \
    lap = A + (size_t)((mt_ + mt_off) * BM + crow_) * lda + epi.aoff(nt_) + kc;                     \
    lb0 = epi.brow(nt_, crow_); lb1 = epi.brow(nt_, crow_ + 64);                         \
  }
  uint4 r0a0, r0a1, r0a2, r0a3, r0b0, r0b1, r1a0, r1a1, r1a2, r1a3, r1b0, r1b1;
  r0a1 = r0a2 = r0a3 = r1a1 = r1a2 = r1a3 = make_uint4(0, 0, 0, 0);
#define GLOADR(R_, k_)                                                                  \
  {                                                                                      \
    R_##a0 = *(const uint4*)(lap + (k_) * 64);                                           \
    if (AI > 1) R_##a1 = *(const uint4*)(lap + (size_t)64 * lda + (k_) * 64);            \
    if (AI > 2) { R_##a2 = *(const uint4*)(lap + (size_t)128 * lda + (k_) * 64); R_##a3 = *(const uint4*)(lap + (size_t)192 * lda + (k_) * 64); } \
    R_##b0 = lb0 ? *(const uint4*)(lb0 + kc + (k_) * 64) : make_uint4(0, 0, 0, 0);       \
    R_##b1 = lb1 ? *(const uint4*)(lb1 + kc + (k_) * 64) : make_uint4(0, 0, 0, 0);       \
  }
#define SWRITER(sA_, sB_, R_)                                                            \
  {                                                                                      \
    *(uint4*)(sA_ + crow_ * LS + kc) = R_##a0;                                           \
    if (AI > 1) *(uint4*)(sA_ + (crow_ + 64) * LS + kc) = R_##a1;                        \
    if (AI > 2) { *(uint4*)(sA_ + (crow_ + 128) * LS + kc) = R_##a2; *(uint4*)(sA_ + (crow_ + 192) * LS + kc) = R_##a3; } \
    *(uint4*)(sB_ + crow_ * LS + kc) = R_##b0;                                           \
    *(uint4*)(sB_ + (crow_ + 64) * LS + kc) = R_##b1;                                    \
  }
#define COMPUTE(sA_, sB_)                                                                \
  {                                                                                      \
    _Pragma("unroll") for (int ks = 0; ks < 4; ++ks) {                                   \
      bf16x8 af[MI], bg[2];                                                              \
      _Pragma("unroll") for (int mi = 0; mi < MI; ++mi) af[mi] = *(const bf16x8*)(sA_ + (wm * (BM / 4) + mi * 32 + l31) * LS + ks * 16 + hh * 8); \
      _Pragma("unroll") for (int ni = 0; ni < 2; ++ni) bg[ni] = *(const bf16x8*)(sB_ + (wn * 64 + ni * 32 + l31) * LS + ks * 16 + hh * 8); \
      _Pragma("unroll") for (int mi = 0; mi < MI; ++mi)                                  \
        _Pragma("unroll") for (int ni = 0; ni < 2; ++ni) acc[mi][ni] = MFMA32(af[mi], bg[ni], acc[mi][ni]); \
    }                                                                                    \
  }
  SETLOAD(ltile);
  GLOADR(r0, 0);
  GLOADR(r1, 1);
  SWRITER(sA0, sB0, r0);
  LDS_BARRIER();
  while (true) {
    const int band = ctile / (4 * NT), within = ctile - band * 4 * NT;
    const int nt = within >> 2, mt = band * 4 + (within & 3);
    const int m0 = (mt + mt_off) * BM;
    f32x16 acc[MI][2];
#pragma unroll
    for (int mi = 0; mi < MI; ++mi)
#pragma unroll
      for (int ni = 0; ni < 2; ++ni)
#pragma unroll
        for (int e = 0; e < 16; ++e) acc[mi][ni][e] = 0.f;
    for (int kt = 0; kt < KT; kt += 2) {
      int lk = kt + 2;
      if (lk == KT) {
        lk = 0; ltile += G; lvalid = ltile < ntiles;
        if (lvalid) SETLOAD(ltile);
      }
      if (lvalid) GLOADR(r0, lk);
      __builtin_amdgcn_sched_barrier(0);
      COMPUTE(sA0, sB0);
      __builtin_amdgcn_sched_barrier(0);
      SWRITER(sA1, sB1, r1);
      LDS_BARRIER();
      if (lvalid) GLOADR(r1, lk + 1);
      __builtin_amdgcn_sched_barrier(0);
      COMPUTE(sA1, sB1);
      __builtin_amdgcn_sched_barrier(0);
      if (kt + 2 < KT) { SWRITER(sA0, sB0, r0); LDS_BARRIER(); }
    }
    LDS_BARRIER();
    if (Epi::STAGED) {
#pragma unroll
      for (int mi = 0; mi < MI; ++mi)
#pragma unroll
        for (int ni = 0; ni < 2; ++ni)
#pragma unroll
          for (int reg = 0; reg < 16; ++reg)
            stg[(wm * (BM / 4) + mi * 32 + crow(reg, hh)) * 132 + wn * 64 + ni * 32 + l31] = acc[mi][ni][reg];
      __syncthreads();
#pragma unroll 4
      for (int idx = tid; idx < BM * 32; idx += NTHR) {
        const int row = idx >> 5, c4 = (idx & 31) * 4;
        epi.store_row4(nt, m0 + row, c4, stg + row * 132);
      }
      __syncthreads();
    } else {
#pragma unroll
      for (int mi = 0; mi < MI; ++mi)
#pragma unroll
        for (int g = 0; g < 4; ++g) {
          int row0 = m0 + wm * (BM / 4) + mi * 32 + 8 * g + 4 * hh;
          float v0[4] = {acc[mi][0][4 * g], acc[mi][0][4 * g + 1], acc[mi][0][4 * g + 2], acc[mi][0][4 * g + 3]};
          float v1[4] = {acc[mi][1][4 * g], acc[mi][1][4 * g + 1], acc[mi][1][4 * g + 2], acc[mi][1][4 * g + 3]};
          epi.store4(nt, row0, wn, l31, v0, v1);
        }
    }
    ctile += G;
    if (ctile >= ntiles) break;
    SWRITER(sA0, sB0, r0);
    __syncthreads();
  }
#undef SETLOAD
#undef GLOADR
#undef SWRITER
#undef COMPUTE
}

template <class Epi>
DI void gemm_phase_big(const bfr* A, int lda, int K, int NT, const Epi& epi, char* lds) {
  constexpr int LS = 72;
  constexpr int LT_ = 256 * LS;
  bfr* sA0 = (bfr*)lds; bfr* sB0 = sA0 + LT_; bfr* sA1 = sB0 + LT_; bfr* sB1 = sA1 + LT_;
  float* stg = (float*)lds;
  const int tid = tid_(), lane = tid & 63, w = tid >> 6, wm = w >> 1, wn = w & 1, l31 = lane & 31, hh = lane >> 5;
  const int MT = T / 256, KT = K / 64;
  const int crow_ = tid >> 3, kc = (tid & 7) * 8;
  const int G = gridDim.x, bid = bid_();
  const int ntiles = MT * NT;
  int ctile = (bid & 7) * (G >> 3) + (bid >> 3);
  if (ctile >= ntiles) return;
  int ltile = ctile;
  const bfr *lap, *lbp;
  bool lv0 = true, lv1 = true, lv2 = true, lv3 = true;
  bool lvalid = true;
  const size_t bstr = epi.bstride();
#define SETLOAD(t_)                                                                      \
  {                                                                                      \
    const int band_ = (t_) / (4 * NT), within_ = (t_) - band_ * 4 * NT;                  \
    const int nt_ = within_ >> 2, mt_ = band_ * 4 + (within_ & 3);                       \
    lap = A + (size_t)(mt_ * 256 + crow_) * lda + kc;                                    \
    lbp = epi.bbase(nt_, crow_) + kc;                                                    \
    if (Epi::BCHECK) { lv0 = epi.bvalid(nt_, crow_, 0); lv1 = epi.bvalid(nt_, crow_, 1); lv2 = epi.bvalid(nt_, crow_, 2); lv3 = epi.bvalid(nt_, crow_, 3); } \
  }
  uint4 ra0, ra1, ra2, ra3, rb0, rb1, rb2, rb3;
#define GLOADR(k_)                                                                       \
  {                                                                                      \
    ra0 = *(const uint4*)(lap + (k_) * 64);                                              \
    ra1 = *(const uint4*)(lap + (size_t)64 * lda + (k_) * 64);                           \
    ra2 = *(const uint4*)(lap + (size_t)128 * lda + (k_) * 64);                          \
    ra3 = *(const uint4*)(lap + (size_t)192 * lda + (k_) * 64);                          \
    rb0 = (!Epi::BCHECK || lv0) ? *(const uint4*)(lbp + (k_) * 64) : make_uint4(0, 0, 0, 0);            \
    rb1 = (!Epi::BCHECK || lv1) ? *(const uint4*)(lbp + bstr + (k_) * 64) : make_uint4(0, 0, 0, 0);     \
    rb2 = (!Epi::BCHECK || lv2) ? *(const uint4*)(lbp + 2 * bstr + (k_) * 64) : make_uint4(0, 0, 0, 0); \
    rb3 = (!Epi::BCHECK || lv3) ? *(const uint4*)(lbp + 3 * bstr + (k_) * 64) : make_uint4(0, 0, 0, 0); \
  }
#define SWRITER(sA_, sB_)                                                                \
  {                                                                                      \
    *(uint4*)(sA_ + crow_ * LS + kc) = ra0; *(uint4*)(sA_ + (crow_ + 64) * LS + kc) = ra1; \
    *(uint4*)(sA_ + (crow_ + 128) * LS + kc) = ra2; *(uint4*)(sA_ + (crow_ + 192) * LS + kc) = ra3; \
    *(uint4*)(sB_ + crow_ * LS + kc) = rb0; *(uint4*)(sB_ + (crow_ + 64) * LS + kc) = rb1; \
    *(uint4*)(sB_ + (crow_ + 128) * LS + kc) = rb2; *(uint4*)(sB_ + (crow_ + 192) * LS + kc) = rb3; \
  }
#define COMPUTE(sA_, sB_)                                                                \
  {                                                                                      \
    _Pragma("unroll") for (int ks = 0; ks < 4; ++ks) {                                   \
      bf16x8 af[2], bg[4];                                                               \
      _Pragma("unroll") for (int mi = 0; mi < 2; ++mi) af[mi] = *(const bf16x8*)(sA_ + (wm * 64 + mi * 32 + l31) * LS + ks * 16 + hh * 8); \
      _Pragma("unroll") for (int ni = 0; ni < 4; ++ni) bg[ni] = *(const bf16x8*)(sB_ + (wn * 128 + ni * 32 + l31) * LS + ks * 16 + hh * 8); \
      _Pragma("unroll") for (int mi = 0; mi < 2; ++mi)                                   \
        _Pragma("unroll") for (int ni = 0; ni < 4; ++ni) acc[mi][ni] = MFMA32(af[mi], bg[ni], acc[mi][ni]); \
    }                                                                                    \
  }
  SETLOAD(ltile);
  GLOADR(0);
  SWRITER(sA0, sB0);
  __syncthreads();
  while (true) {
    const int band = ctile / (4 * NT), within = ctile - band * 4 * NT;
    const int nt = within >> 2, mt = band * 4 + (within & 3);
    const int m0 = mt * 256;
    f32x16 acc[2][4];
#pragma unroll
    for (int mi = 0; mi < 2; ++mi)
#pragma unroll
      for (int ni = 0; ni < 4; ++ni)
#pragma unroll
        for (int e = 0; e < 16; ++e) acc[mi][ni][e] = 0.f;
    for (int kt = 0; kt < KT; kt += 2) {
      GLOADR(kt + 1);
      __builtin_amdgcn_sched_barrier(0);
      COMPUTE(sA0, sB0);
      __builtin_amdgcn_sched_barrier(0);
      SWRITER(sA1, sB1);
      __syncthreads();
      int lk = kt + 2;
      if (lk == KT) {
        lk = 0; ltile += G; lvalid = ltile < ntiles;
        if (lvalid) SETLOAD(ltile);
      }
      if (lvalid) GLOADR(lk);
      __builtin_amdgcn_sched_barrier(0);
      COMPUTE(sA1, sB1);
      __builtin_amdgcn_sched_barrier(0);
      if (kt + 2 < KT) { SWRITER(sA0, sB0); }
      __syncthreads();
    }
    if (Epi::DUAL) {
#pragma unroll
      for (int mi = 0; mi < 2; ++mi)
#pragma unroll
        for (int q = 0; q < 2; ++q)
#pragma unroll
          for (int reg = 0; reg < 16; ++reg)
            stg[(wm * 64 + mi * 32 + crow(reg, hh)) * 132 + wn * 64 + q * 32 + l31] = epi.dual(acc[mi][2 * q][reg], acc[mi][2 * q + 1][reg]);
      __syncthreads();
#pragma unroll 4
      for (int idx = tid; idx < 256 * 32; idx += NTHR) {
        const int row = idx >> 5, c4 = (idx & 31) * 4;
        epi.store_dual4(nt, m0 + row, c4, *(const float4*)(stg + row * 132 + c4));
      }
      __syncthreads();
    } else if (Epi::STAGED) {
#pragma unroll
      for (int half = 0; half < 2; ++half) {
        if (wn == half) {
#pragma unroll
          for (int mi = 0; mi < 2; ++mi)
#pragma unroll
            for (int ni = 0; ni < 4; ++ni)
#pragma unroll
              for (int reg = 0; reg < 16; ++reg)
                stg[(wm * 64 + mi * 32 + crow(reg, hh)) * 132 + ni * 32 + l31] = acc[mi][ni][reg];
        }
        __syncthreads();
#pragma unroll 4
        for (int idx = tid; idx < 256 * 32; idx += NTHR) {
          const int row = idx >> 5, c4 = (idx & 31) * 4;
          epi.store_row4b(nt, half, m0 + row, c4, stg + row * 132);
        }
        __syncthreads();
      }
    } else {
#pragma unroll
      for (int mi = 0; mi < 2; ++mi)
#pragma unroll
        for (int ni = 0; ni < 4; ++ni)
#pragma unroll
          for (int g = 0; g < 4; ++g) {
            int row0 = m0 + wm * 64 + mi * 32 + 8 * g + 4 * hh;
            float v0[4] = {acc[mi][ni][4 * g], acc[mi][ni][4 * g + 1], acc[mi][ni][4 * g + 2], acc[mi][ni][4 * g + 3]};
            epi.store4b(nt * 256 + wn * 128 + ni * 32 + l31, row0, v0);
          }
    }
    ctile += G;
    if (ctile >= ntiles) break;
    SWRITER(sA0, sB0);
    __syncthreads();
  }
#undef SETLOAD
#undef GLOADR
#undef SWRITER
#undef COMPUTE
}

template <class Epi>
DI void gemm_phase_glds(const bfr* A, int NT, const Epi& epi, char* lds, int K = 1024, int MT = T / 256) {
  constexpr int STGB = 65536;
  float* stg = (float*)lds;
  const int tid = tid_(), lane = tid & 63, w = tid >> 6, wm = w >> 1, wn = w & 1, l31 = lane & 31, hh = lane >> 5;
  const int KT = K >> 6;
  const int G = gridDim.x, bid = bid_();
  const int ntiles = MT * NT;
  const int lrow = lane >> 3;
  const int lc = (lane & 7) ^ ((4 * (w & 1) + (lrow >> 1)) & 7);
  const int swz = (l31 >> 1) & 7;
  const int wofs = __builtin_amdgcn_readfirstlane(w) * 1024;
  const size_t bstr = epi.bstride();
#define WAITV(n_) asm volatile("s_waitcnt vmcnt(" #n_ ")" ::: "memory")
#define RAWBAR() { asm volatile("s_waitcnt lgkmcnt(0)" ::: "memory"); __builtin_amdgcn_s_barrier(); asm volatile("" ::: "memory"); }
#define GLDS(g_, l_) __builtin_amdgcn_global_load_lds((const unsigned*)(g_), (__attribute__((address_space(3))) unsigned*)(l_), 16, 0, 0)
#define ISSUE(s_, slot_)                                                                 \
  {                                                                                      \
    char* sb_ = lds + (slot_) * STGB + wofs;                                             \
    GLDS(ga + (s_) * 64, sb_); GLDS(ga + (size_t)64 * K + (s_) * 64, sb_ + 8192);        \
    GLDS(ga + (size_t)128 * K + (s_) * 64, sb_ + 16384); GLDS(ga + (size_t)192 * K + (s_) * 64, sb_ + 24576); \
    GLDS(gb + (s_) * 64, sb_ + 32768); GLDS(gb + bstr + (s_) * 64, sb_ + 40960);         \
    GLDS(gb + 2 * bstr + (s_) * 64, sb_ + 49152); GLDS(gb + 3 * bstr + (s_) * 64, sb_ + 57344); \
  }
#define COMPUTE(slot_)                                                                   \
  {                                                                                      \
    const char* sa_ = lds + (slot_) * STGB + (wm * 64 + l31) * 128;                      \
    const char* sb_ = lds + (slot_) * STGB + 32768 + (wn * 128 + l31) * 128;             \
    _Pragma("unroll") for (int ks = 0; ks < 4; ++ks) {                                   \
      const int ok_ = ((ks * 2 + hh) ^ swz) * 16;                                        \
      bf16x8 af[2], bg[4];                                                               \
      _Pragma("unroll") for (int mi = 0; mi < 2; ++mi) af[mi] = *(const bf16x8*)(sa_ + mi * 4096 + ok_); \
      _Pragma("unroll") for (int ni = 0; ni < 4; ++ni) bg[ni] = *(const bf16x8*)(sb_ + ni * 4096 + ok_); \
      _Pragma("unroll") for (int mi = 0; mi < 2; ++mi)                                   \
        _Pragma("unroll") for (int ni = 0; ni < 4; ++ni) acc[mi][ni] = MFMA32(af[mi], bg[ni], acc[mi][ni]); \
    }                                                                                    \
  }
  for (int ctile = (bid & 7) * (G >> 3) + (bid >> 3); ctile < ntiles; ctile += G) {
    const int band = ctile / (4 * NT), within = ctile - band * 4 * NT;
    const int nt = within >> 2, mt = band * 4 + (within & 3);
    const int m0 = mt * 256;
    const bfr* ga = A + (size_t)(m0 + 8 * w + lrow) * K + lc * 8;
    const bfr* gb = epi.bbase(nt, 8 * w + lrow) + lc * 8;
    f32x16 acc[2][4];
#pragma unroll
    for (int mi = 0; mi < 2; ++mi)
#pragma unroll
      for (int ni = 0; ni < 4; ++ni)
#pragma unroll
        for (int e = 0; e < 16; ++e) acc[mi][ni][e] = 0.f;
    ISSUE(0, 0);
    WAITV(0); RAWBAR();
    for (int s2 = 0; s2 < KT; s2 += 2) {
      ISSUE(s2 + 1, 1); COMPUTE(0); WAITV(0); RAWBAR();
      if (s2 + 2 < KT) ISSUE(s2 + 2, 0);
      COMPUTE(1); WAITV(0); RAWBAR();
    }
    if (Epi::DUAL) {
#pragma unroll
      for (int mi = 0; mi < 2; ++mi)
#pragma unroll
        for (int q = 0; q < 2; ++q)
#pragma unroll
          for (int reg = 0; reg < 16; ++reg)
            stg[(wm * 64 + mi * 32 + crow(reg, hh)) * 132 + wn * 64 + q * 32 + l31] = epi.dual(acc[mi][2 * q][reg], acc[mi][2 * q + 1][reg]);
      __syncthreads();
#pragma unroll 4
      for (int idx = tid; idx < 256 * 32; idx += NTHR) {
        const int row = idx >> 5, c4 = (idx & 31) * 4;
        epi.store_dual4(nt, m0 + row, c4, *(const float4*)(stg + row * 132 + c4));
      }
      __syncthreads();
    } else if (Epi::STAGE16 && epi.use16(nt)) {
      bfr* st16 = (bfr*)lds;
#pragma unroll
      for (int mi = 0; mi < 2; ++mi)
#pragma unroll
        for (int ni = 0; ni < 4; ++ni)
#pragma unroll
          for (int reg = 0; reg < 16; ++reg)
            st16[(wm * 64 + mi * 32 + crow(reg, hh)) * 264 + wn * 128 + ni * 32 + l31] = f2bf(acc[mi][ni][reg]);
      __syncthreads();
#pragma unroll 4
      for (int idx = tid; idx < 256 * 32; idx += NTHR) {
        const int row = idx >> 5, c8 = (idx & 31) * 8;
        epi.store_row8(nt, m0 + row, c8, *(const uint4*)(st16 + row * 264 + c8));
      }
      __syncthreads();
    } else if (Epi::STAGED) {
#pragma unroll
      for (int half = 0; half < 2; ++half) {
        if (wn == half) {
#pragma unroll
          for (int mi = 0; mi < 2; ++mi)
#pragma unroll
            for (int ni = 0; ni < 4; ++ni)
#pragma unroll
              for (int reg = 0; reg < 16; ++reg)
                stg[(wm * 64 + mi * 32 + crow(reg, hh)) * 132 + ni * 32 + l31] = acc[mi][ni][reg];
        }
        __syncthreads();
#pragma unroll 4
        for (int idx = tid; idx < 256 * 32; idx += NTHR) {
          const int row = idx >> 5, c4 = (idx & 31) * 4;
          epi.store_row4b(nt, half, m0 + row, c4, stg + row * 132);
        }
        __syncthreads();
      }
    } else {
#pragma unroll
      for (int mi = 0; mi < 2; ++mi)
#pragma unroll
        for (int ni = 0; ni < 4; ++ni)
#pragma unroll
          for (int g = 0; g < 4; ++g) {
            int row0 = m0 + wm * 64 + mi * 32 + 8 * g + 4 * hh;
            float v0[4] = {acc[mi][ni][4 * g], acc[mi][ni][4 * g + 1], acc[mi][ni][4 * g + 2], acc[mi][ni][4 * g + 3]};
            epi.store4b(nt * 256 + wn * 128 + ni * 32 + l31, row0, v0);
          }
      __syncthreads();
    }
  }
#undef WAITV
#undef RAWBAR
#undef GLDS
#undef ISSUE
#undef COMPUTE
}

template <class Epi>
DI void gemm_phase_glds16(const bfr* A, int NT, const Epi& epi, char* lds, int K = 1024, int MT = T / 256, bool skipctx = false) {
  constexpr int STGB = 65536;
  float* stg = (float*)lds;
  const int tid = tid_(), lane = tid & 63, w = tid >> 6, wm = w >> 1, wn = w & 1, l15 = lane & 15, q4 = lane >> 4;
  const int KT = K >> 6;
  const int G = gridDim.x, bid = bid_();
  const int ntiles = MT * NT;
  const int lrow = lane >> 3;
  const int lc = (lane & 7) ^ ((4 * (w & 1) + (lrow >> 1)) & 7);
  const int swz = (l15 >> 1) & 7;
  const int wofs = __builtin_amdgcn_readfirstlane(w) * 1024;
  const size_t bstr = epi.bstride();
#define WAITV(n_) asm volatile("s_waitcnt vmcnt(" #n_ ")" ::: "memory")
#define RAWBAR() { asm volatile("s_waitcnt lgkmcnt(0)" ::: "memory"); __builtin_amdgcn_s_barrier(); asm volatile("" ::: "memory"); }
#define GLDS(g_, l_) __builtin_amdgcn_global_load_lds((const unsigned*)(g_), (__attribute__((address_space(3))) unsigned*)(l_), 16, 0, 0)
#define ISSUE(s_, slot_)                                                                 \
  {                                                                                      \
    char* sb_ = lds + (slot_) * STGB + wofs;                                             \
    GLDS(ga + (s_) * 64, sb_); GLDS(ga + (size_t)64 * K + (s_) * 64, sb_ + 8192);        \
    GLDS(ga + (size_t)128 * K + (s_) * 64, sb_ + 16384); GLDS(ga + (size_t)192 * K + (s_) * 64, sb_ + 24576); \
    GLDS(gb + (s_) * 64, sb_ + 32768); GLDS(gb + bstr + (s_) * 64, sb_ + 40960);         \
    GLDS(gb + 2 * bstr + (s_) * 64, sb_ + 49152); GLDS(gb + 3 * bstr + (s_) * 64, sb_ + 57344); \
  }
#define COMPUTE(slot_)                                                                   \
  {                                                                                      \
    const char* sa_ = lds + (slot_) * STGB + (wm * 64 + l15) * 128;                      \
    const char* sb_ = lds + (slot_) * STGB + 32768 + (wn * 128 + l15) * 128;             \
    _Pragma("unroll") for (int ks = 0; ks < 2; ++ks) {                                   \
      const int ok_ = ((ks * 4 + q4) ^ swz) * 16;                                        \
      bf16x8 af[4];                                                                      \
      _Pragma("unroll") for (int mi = 0; mi < 4; ++mi) af[mi] = *(const bf16x8*)(sa_ + mi * 2048 + ok_); \
      _Pragma("unroll") for (int nh = 0; nh < 2; ++nh) {                                 \
        bf16x8 bg[4];                                                                    \
        _Pragma("unroll") for (int ni = 0; ni < 4; ++ni) bg[ni] = *(const bf16x8*)(sb_ + (nh * 4 + ni) * 2048 + ok_); \
        _Pragma("unroll") for (int mi = 0; mi < 4; ++mi)                                 \
          _Pragma("unroll") for (int ni = 0; ni < 4; ++ni) acc[mi][nh * 4 + ni] = __builtin_amdgcn_mfma_f32_16x16x32_bf16(af[mi], bg[ni], acc[mi][nh * 4 + ni], 0, 0, 0); \
        __builtin_amdgcn_sched_barrier(0);                                               \
      }                                                                                  \
    }                                                                                    \
  }
  for (int ctile = (bid & 7) * (G >> 3) + (bid >> 3); ctile < ntiles; ctile += G) {
    const int band = ctile / (4 * NT), within = ctile - band * 4 * NT;
    const int nt = within >> 2, mte = band * 4 + (within & 3);
    const int mt = skipctx ? mte + (mte >> 5) + 1 : mte;
    const int m0 = mt * 256;
    const bfr* ga = A + (size_t)(m0 + 8 * w + lrow) * K + lc * 8;
    const bfr* gb = epi.bbase16(nt, 8 * w + lrow) + lc * 8;
    f32x4_t acc[4][8];
#pragma unroll
    for (int mi = 0; mi < 4; ++mi)
#pragma unroll
      for (int ni = 0; ni < 8; ++ni)
#pragma unroll
        for (int e = 0; e < 4; ++e) acc[mi][ni][e] = 0.f;
    ISSUE(0, 0);
    WAITV(0); RAWBAR();
    for (int s2 = 0; s2 < KT; s2 += 2) {
      ISSUE(s2 + 1, 1); COMPUTE(0); WAITV(0); RAWBAR();
      if (s2 + 2 < KT) ISSUE(s2 + 2, 0);
      COMPUTE(1); WAITV(0); RAWBAR();
    }
    if (Epi::DUAL) {
#pragma unroll
      for (int mi = 0; mi < 4; ++mi)
#pragma unroll
        for (int q = 0; q < 4; ++q)
#pragma unroll
          for (int e = 0; e < 4; ++e)
            stg[(wm * 64 + mi * 16 + 4 * q4 + e) * 132 + wn * 64 + q * 16 + l15] = epi.dual(acc[mi][2 * q][e], acc[mi][2 * q + 1][e]);
      __syncthreads();
#pragma unroll 4
      for (int idx = tid; idx < 256 * 32; idx += NTHR) {
        const int row = idx >> 5, c4 = (idx & 31) * 4;
        epi.store_dual4(nt, m0 + row, c4, *(const float4*)(stg + row * 132 + c4));
      }
      __syncthreads();
    } else if (Epi::STAGE16 && epi.use16(nt)) {
      bfr* st16 = (bfr*)lds;
#pragma unroll
      for (int mi = 0; mi < 4; ++mi)
#pragma unroll
        for (int ni = 0; ni < 8; ++ni)
#pragma unroll
          for (int e = 0; e < 4; ++e)
            st16[(wm * 64 + mi * 16 + 4 * q4 + e) * 264 + wn * 128 + ni * 16 + l15] = f2bf(acc[mi][ni][e]);
      __syncthreads();
#pragma unroll 4
      for (int idx = tid; idx < 256 * 32; idx += NTHR) {
        const int row = idx >> 5, c8 = (idx & 31) * 8;
        epi.store_row8(nt, m0 + row, c8, *(const uint4*)(st16 + row * 264 + c8));
      }
      __syncthreads();
    } else if (Epi::STAGED) {
#pragma unroll
      for (int half = 0; half < 2; ++half) {
        if (wn == half) {
#pragma unroll
          for (int mi = 0; mi < 4; ++mi)
#pragma unroll
            for (int ni = 0; ni < 8; ++ni)
#pragma unroll
              for (int e = 0; e < 4; ++e)
                stg[(wm * 64 + mi * 16 + 4 * q4 + e) * 132 + ni * 16 + l15] = acc[mi][ni][e];
        }
        __syncthreads();
#pragma unroll 4
        for (int idx = tid; idx < 256 * 32; idx += NTHR) {
          const int row = idx >> 5, c4 = (idx & 31) * 4;
          epi.store_row4b(nt, half, m0 + row, c4, stg + row * 132);
        }
        __syncthreads();
      }
    } else {
#pragma unroll
      for (int mi = 0; mi < 4; ++mi)
#pragma unroll
        for (int ni = 0; ni < 8; ++ni) {
          int row0 = m0 + wm * 64 + mi * 16 + 4 * q4;
          float v0[4] = {acc[mi][ni][0], acc[mi][ni][1], acc[mi][ni][2], acc[mi][ni][3]};
          epi.store4b(nt * 256 + wn * 128 + ni * 16 + l15, row0, v0);
        }
      __syncthreads();
    }
  }
#undef WAITV
#undef RAWBAR
#undef GLDS
#undef ISSUE
#undef COMPUTE
}


struct EpiGdnIn {
  static constexpr bool STAGE16 = true; static constexpr bool DUAL = false; static constexpr bool BCHECK = true; static constexpr bool STAGED = true;
  const bfr* W; bfr* PR; bfr* Z; float* AB;
  DI float dual(float a, float) const { return a; }
  DI void store_dual4(int, int, int, float4) const {}
  DI const bfr* browv(int nt, int v) const { int col = nt * 256 + v; col = col < GDN_IN ? col : GDN_IN - 1; return W + (size_t)col * 1024; }
  DI bool use16(int nt) const { return nt < 16; }
  DI void store_row8(int nt, int row, int c8, uint4 v) const { const int col = nt * 256 + c8; if (col < 3072) *(uint4*)(PR + (size_t)row * 3072 + col) = v; else *(uint4*)(Z + (size_t)row * 1024 + col - 3072) = v; }
  DI const bfr* bbase16(int nt, int r) const { return bbase(nt, r); }
  DI int aoff(int) const { return 0; }
  DI const bfr* brow(int nt, int v) const { int col = nt * 128 + v; return col < GDN_IN ? W + (size_t)col * 1024 : nullptr; }
  DI void store4b(int, int, const float*) const {}
  DI void store4(int, int, int, int, const float*, const float*) const {}
  DI size_t bstride() const { return (size_t)64 * 1024; }
  DI const bfr* bbase(int nt, int r) const { return W + (size_t)(nt * 256 + r) * 1024; }
  DI bool bvalid(int nt, int r, int i) const { return nt * 256 + r + 64 * i < GDN_IN; }
  DI void store_row4b(int nt, int half, int row, int c4, const float* rp) const { store_row4(nt * 2 + half, row, c4, rp); }
  DI void store_row4(int nt, int row, int c4, const float* rp) const {
    const int col = nt * 128 + c4;
    const float4 v = *(const float4*)(rp + c4);
    if (col < 3072) *(uint2*)(PR + (size_t)row * 3072 + col) = pack4(v.x, v.y, v.z, v.w);
    else if (col < 4096) *(uint2*)(Z + (size_t)row * 1024 + col - 3072) = pack4(v.x, v.y, v.z, v.w);
    else if (col < GDN_IN) *(float4*)(AB + (size_t)row * 32 + col - 4096) = v;
  }
};
struct EpiPlain {
  static constexpr bool STAGE16 = true; static constexpr bool DUAL = false; static constexpr bool BCHECK = false; static constexpr bool STAGED = true;
  const bfr* W; bfr* O; int ldo; int K;
  DI float dual(float a, float) const { return a; }
  DI void store_dual4(int, int, int, float4) const {}
  DI const bfr* browv(int nt, int v) const { return W + (size_t)(nt * 256 + v) * K; }
  DI bool use16(int) const { return true; }
  DI void store_row8(int nt, int row, int c8, uint4 v) const { *(uint4*)(O + (size_t)row * ldo + nt * 256 + c8) = v; }
  DI const bfr* bbase16(int nt, int r) const { return bbase(nt, r); }
  DI int aoff(int) const { return 0; }
  DI const bfr* brow(int nt, int v) const { return W + (size_t)(nt * 128 + v) * K; }
  DI void store4b(int, int, const float*) const {}
  DI void store4(int, int, int, int, const float*, const float*) const {}
  DI size_t bstride() const { return (size_t)64 * K; }
  DI const bfr* bbase(int nt, int r) const { return W + (size_t)(nt * 256 + r) * K; }
  DI bool bvalid(int, int, int) const { return true; }
  DI void store_row4b(int nt, int half, int row, int c4, const float* rp) const { store_row4(nt * 2 + half, row, c4, rp); }
  DI void store_row4(int nt, int row, int c4, const float* rp) const {
    const float4 v = *(const float4*)(rp + c4);
    *(uint2*)(O + (size_t)row * ldo + nt * 128 + c4) = pack4(v.x, v.y, v.z, v.w);
  }
};
struct EpiHgIn {
  static constexpr bool STAGE16 = true; static constexpr bool DUAL = false; static constexpr bool BCHECK = false; static constexpr bool STAGED = false;
  const bfr* W; char* ws;
  DI float dual(float a, float) const { return a; }
  DI void store_dual4(int, int, int, float4) const {}
  DI const bfr* browv(int nt, int v) const { return W + (size_t)(nt * 256 + v) * 1024; }
  DI bool use16(int nt) const { const int reg = nt >> 2; return reg == 0 || reg == 4; }
  DI void store_row8(int nt, int row, int c8, uint4 v) const { const int col = nt * 256 + c8; bfr* O = (bfr*)(ws + ((col >> 10) == 0 ? UB : 5 * UB)); *(uint4*)(O + (size_t)row * 1024 + (col & 1023)) = v; }
  DI const bfr* bbase16(int nt, int r) const { return bbase(nt, r); }
  DI int aoff(int) const { return 0; }
  DI const bfr* brow(int nt, int v) const { return W + (size_t)(nt * 128 + v) * 1024; }
  DI void store_row4(int, int, int, const float*) const {}
  DI void store_row4b(int, int, int, int, const float*) const {}
  DI size_t bstride() const { return (size_t)64 * 1024; }
  DI const bfr* bbase(int nt, int r) const { return W + (size_t)(nt * 256 + r) * 1024; }
  DI bool bvalid(int, int, int) const { return true; }
  DI void store4b(int col, int row0, const float* a) const {
    int reg = col >> 10, cc = col & 1023;
    if (reg == 0 || reg == 4) {
      bfr* O = (bfr*)(ws + (reg == 0 ? UB : 5 * UB));
#pragma unroll
      for (int e = 0; e < 4; ++e) O[(size_t)(row0 + e) * 1024 + cc] = f2bf(a[e]);
    } else {
      bfr* O = (bfr*)(ws + (size_t)(reg + 1) * UB);
      size_t o = ((size_t)(row0 >> 6) * 8 + (cc >> 7)) * 8192 + (cc & 127) * 64 + (row0 & 63);
      uint2 u; u.x = pack2(a[0], a[1]); u.y = pack2(a[2], a[3]);
      *(uint2*)(O + o) = u;
    }
  }
  DI void store4(int nt, int row0, int wn, int l31, const float* a0, const float* a1) const {
#pragma unroll
    for (int ni = 0; ni < 2; ++ni) {
      const float* a = ni ? a1 : a0;
      int col = nt * 128 + wn * 64 + ni * 32 + l31;
      int reg = col >> 10, cc = col & 1023;
      if (reg == 0 || reg == 4) {
        bfr* O = (bfr*)(ws + (reg == 0 ? UB : 5 * UB));
#pragma unroll
        for (int e = 0; e < 4; ++e) O[(size_t)(row0 + e) * 1024 + cc] = f2bf(a[e]);
      } else {
        bfr* O = (bfr*)(ws + (size_t)(reg + 1) * UB);
        size_t o = ((size_t)(row0 >> 6) * 8 + (cc >> 7)) * 8192 + (cc & 127) * 64 + (row0 & 63);
        uint2 u; u.x = pack2(a[0], a[1]); u.y = pack2(a[2], a[3]);
        *(uint2*)(O + o) = u;
      }
    }
  }
};
struct EpiResid {
  static constexpr bool STAGE16 = false; static constexpr bool DUAL = false; static constexpr bool BCHECK = false; static constexpr bool STAGED = true;
  const bfr* W; const Params* p; const float* gate; bool colmaj; bool first; int K;
  DI float dual(float a, float) const { return a; }
  DI void store_dual4(int, int, int, float4) const {}
  DI const bfr* browv(int nt, int v) const { return W + (size_t)(nt * 256 + v) * K; }
  DI void store_row4b(int nt, int half, int row, int c4, const float* rp) const { store_row4(nt * 2 + half, row, c4, rp); }
  DI void store4b(int, int, const float*) const {}
  DI size_t bstride() const { return (size_t)64 * K; }
  DI const bfr* bbase(int nt, int r) const { return W + (size_t)(nt * 256 + r) * K; }
  DI bool use16(int) const { return false; }
  DI void store_row8(int, int, int, uint4) const {}
  DI const bfr* bbase16(int nt, int r) const { return bbase(nt, r); }
  DI int aoff(int) const { return 0; }
  DI const bfr* brow(int nt, int v) const { return W + (size_t)(nt * 128 + v) * K; }
  DI void store4(int, int, int, int, const float*, const float*) const {}
  DI void store_row4(int nt, int row, int c4, const float* rp) const {
    const float* xin; float* xout; int mr;
    xrow_ptr(*p, row, colmaj, first, xin, xout, mr);
    const int col = nt * 128 + c4;
    const float4 v = *(const float4*)(rp + c4);
    const float4 x = *(const float4*)(xin + col);
    const float4 g = *(const float4*)(gate + mr * 6144 + col);
    float4 o; o.x = x.x + g.x * v.x; o.y = x.y + g.y * v.y; o.z = x.z + g.z * v.z; o.w = x.w + g.w * v.w;
    *(float4*)(xout + col) = o;
  }
};
struct EpiFfnUp {
  static constexpr bool STAGE16 = false; static constexpr bool DUAL = true; static constexpr bool BCHECK = false; static constexpr bool STAGED = true;
  const bfr* W1T; bfr* HID;
  DI float dual(float a, float b) const { return siluf_(a) * b; }
  DI void store_dual4(int nt, int row, int c4, float4 v) const { *(uint2*)(HID + (size_t)row * FFH + nt * 128 + c4) = pack4(v.x, v.y, v.z, v.w); }
  DI const bfr* browv(int nt, int v) const { return W1T + (((v >> 5) & 1) ? WB_W3 - WB_W1 : (size_t)0) + (size_t)(nt * 128 + (v >> 7) * 64 + ((v >> 6) & 1) * 32 + (v & 31)) * 1024; }
  DI bool use16(int) const { return false; }
  DI void store_row8(int, int, int, uint4) const {}
  DI const bfr* bbase16(int nt, int r) const { return W1T + (((r >> 4) & 1) ? WB_W3 - WB_W1 : (size_t)0) + (size_t)(nt * 128 + (r >> 5) * 16 + (r & 15)) * 1024; }
  DI int aoff(int) const { return 0; }
  DI const bfr* brow(int nt, int v) const {
    int wn_ = v >> 6, ni_ = (v >> 5) & 1, c = v & 31;
    return W1T + (ni_ ? WB_W3 - WB_W1 : (size_t)0) + (size_t)(nt * 64 + wn_ * 32 + c) * 1024;
  }
  DI void store4b(int, int, const float*) const {}
  DI void store4(int, int, int, int, const float*, const float*) const {}
  DI size_t bstride() const { return (size_t)32 * 1024; }
  DI const bfr* bbase(int nt, int r) const { return W1T + (((r >> 5) & 1) ? WB_W3 - WB_W1 : (size_t)0) + (size_t)(nt * 128 + (r & 31)) * 1024; }
  DI bool bvalid(int, int, int) const { return true; }
  DI void store_row4b(int nt, int half, int row, int c4, const float* rp) const { store_row4(nt * 2 + half, row, c4, rp); }
  DI void store_row4(int nt, int row, int c4, const float* rp) const {
    if (c4 & 32) return;
    const float4 a = *(const float4*)(rp + c4), b = *(const float4*)(rp + c4 + 32);
    const int col = nt * 64 + (c4 >> 6) * 32 + (c4 & 31);
    *(uint2*)(HID + (size_t)row * FFH + col) = pack4(siluf_(a.x) * b.x, siluf_(a.y) * b.y, siluf_(a.z) * b.z, siluf_(a.w) * b.w);
  }
};
struct EpiLruGate {
  static constexpr bool STAGE16 = false; static constexpr bool DUAL = false; static constexpr bool BCHECK = false; static constexpr bool STAGED = true;
  const bfr* WG; const float *br, *bi, *lam; const bfr* XR; bfr* LA; bfr* BV;
  DI float dual(float a, float) const { return a; }
  DI void store_dual4(int, int, int, float4) const {}
  DI bool use16(int) const { return false; }
  DI void store_row8(int, int, int, uint4) const {}
  DI int aoff(int nt) const { return ((nt >> 1) & 7) * 128; }
  DI const bfr* brow(int nt, int v) const {
    int wn_ = v >> 6, ni_ = (v >> 5) & 1, c = v & 31;
    int d = nt >> 4, g = (nt >> 1) & 7, half = nt & 1;
    return WG + ((size_t)(((d * 2 + ni_) * 8 + g) * 128) + half * 64 + wn_ * 32 + c) * 128;
  }
  DI void store4(int, int, int, int, const float*, const float*) const {}
  DI void store_row4(int nt, int row, int c4, const float* rp) const {
    if (c4 & 32) return;
    const int d = nt >> 4, g = (nt >> 1) & 7, half = nt & 1;
    const int ch = g * 128 + half * 64 + (c4 >> 6) * 32 + (c4 & 31);
    const float4 a = *(const float4*)(rp + c4), b = *(const float4*)(rp + c4 + 32);
    const float4 vbr = *(const float4*)(br + d * 1024 + ch), vbi = *(const float4*)(bi + d * 1024 + ch), vlm = *(const float4*)(lam + d * 1024 + ch);
    const uint2 xu = *(const uint2*)(XR + (size_t)row * 1024 + ch);
    const float av[4] = {a.x, a.y, a.z, a.w}, bv[4] = {b.x, b.y, b.z, b.w};
    const float rb[4] = {vbr.x, vbr.y, vbr.z, vbr.w}, ib[4] = {vbi.x, vbi.y, vbi.z, vbi.w}, lm[4] = {vlm.x, vlm.y, vlm.z, vlm.w};
    const float xr[4] = {lo2f(xu.x), hi2f(xu.x), lo2f(xu.y), hi2f(xu.y)};
    float la[4], bb[4];
#pragma unroll
    for (int e = 0; e < 4; ++e) {
      float r = sigmoidf_(av[e] + rb[e]);
      float ig = sigmoidf_(bv[e] + ib[e]);
      float sp = __logf(1.f + __expf(-lm[e]));
      la[e] = -8.f * r * sp;
      bb[e] = __builtin_amdgcn_sqrtf(fmaxf(1.f - __expf(2.f * la[e]), 0.f)) * ig * xr[e];
    }
    const size_t o = ((size_t)d * T + row) * 1024 + ch;
    *(uint2*)(LA + o) = pack4(la[0], la[1], la[2], la[3]);
    *(uint2*)(BV + o) = pack4(bb[0], bb[1], bb[2], bb[3]);
  }
};

template <int MODE>
DI void phase_conv(const bfr* in, int ldin, int inoff, bfr* out, int ldo, const float* cw, const float* cb) {
  constexpr int NG = MODE == 0 ? 24 : 8;
  constexpr int C = NG * 128;
  const int hw = tid_() >> 5, l31 = tid_() & 31;
  const int H = bid_() * 16 + hw;
  const int RS = (gridDim.x * 16) / NG;
  const int hd = H % NG, rl = H / NG;
  if (rl >= RS) return;
  const int c = hd * 128 + l31 * 4;
  float4 wv[4];
#pragma unroll
  for (int j = 0; j < 4; ++j) wv[j] = *(const float4*)(cw + j * C + c);
  float4 bv = make_float4(0, 0, 0, 0);
  if (MODE == 1) bv = *(const float4*)(cb + c);
  for (int r0 = rl; r0 < T; r0 += 4 * RS) {
    uint2 u[4][4];
#pragma unroll
    for (int k = 0; k < 4; ++k) {
      const int r = r0 + k * RS;
      const int b = r / LTOK, q = r - b * LTOK;
      const int lo = q < CTX ? 0 : CTX, hi = q < CTX ? CTX : LTOK;
#pragma unroll
      for (int j = 0; j < 4; ++j) {
        const int qq = q + j - 2;
        u[k][j] = make_uint2(0, 0);
        if (r < T && qq >= lo && qq < hi) u[k][j] = *(const uint2*)(in + (size_t)(b * LTOK + qq) * ldin + inoff + c);
      }
    }
#pragma unroll
    for (int k = 0; k < 4; ++k) {
      const int r = r0 + k * RS;
      float y0 = 0, y1 = 0, y2 = 0, y3 = 0;
#pragma unroll
      for (int j = 0; j < 4; ++j) {
        y0 += wv[j].x * lo2f(u[k][j].x); y1 += wv[j].y * hi2f(u[k][j].x); y2 += wv[j].z * lo2f(u[k][j].y); y3 += wv[j].w * hi2f(u[k][j].y);
      }
      if (MODE == 0) {
        y0 = siluf_(y0); y1 = siluf_(y1); y2 = siluf_(y2); y3 = siluf_(y3);
        if (hd < 16) {
          float ss = y0 * y0 + y1 * y1 + y2 * y2 + y3 * y3;
#pragma unroll
          for (int o = 16; o > 0; o >>= 1) ss += __shfl_xor(ss, o);
          float sc = rsqrtf(ss + 1e-6f);
          if (hd < 8) sc *= 0.08838834764831845f;
          y0 *= sc; y1 *= sc; y2 *= sc; y3 *= sc;
        }
      } else {
        y0 += bv.x; y1 += bv.y; y2 += bv.z; y3 += bv.w;
      }
      if (r < T) *(uint2*)(out + (size_t)r * ldo + c) = pack4(y0, y1, y2, y3);
    }
  }
}

DI int ndir_of(int cs, int d) { return d ? (cs < 4 ? 3 - cs : 135 - cs) : cs; }

DI void phase_gdn_intra(const Params& p, int j_layer, char* lds) {
  bfr* sQ = (bfr*)lds;
  bfr* sK = sQ + 64 * 136;
  float* sKK = (float*)(lds + 34816);
  float* sQK = sKK + 64 * 65;
  float* sL = sQK + 64 * 65;
  float* sgc = sL + 2 * 4096;
  float* sbt = sgc + 128;
  float* sTm = sbt + 128;
  const bfr* QKV2 = (const bfr*)p.ws;
  bfr* REC = (bfr*)(p.ws + 3 * UB);
  bfr* KT = (bfr*)(p.ws + 5 * UB);
  const float* AB = (const float*)(p.ws + OFF_AB);
  float* GC = (float*)(p.ws + OFF_GC);
  float* BT = (float*)(p.ws + OFF_BT);
  const float* a_log = p.gdn_a_log + j_layer * 16;
  const float* dtb = p.gdn_dt_bias + j_layer * 16;
  const int tid = tid_(), lane = tid & 63, w = tid >> 6, l31 = lane & 31, hh = lane >> 5;
  uint4 nq0, nq1, nk0, nk1;
#define GI_LOAD(it_)                                                                    \
  {                                                                                     \
    const int cs_ = (it_) % NCH, bh_ = (it_) / NCH;                                      \
    const bfr* g_ = QKV2 + (size_t)((bh_ >> 3) * LTOK + cs_ * 64 + (tid >> 4)) * 3072 + (bh_ & 7) * 128 + (tid & 15) * 8; \
    nq0 = *(const uint4*)g_; nk0 = *(const uint4*)(g_ + 1024);                          \
    nq1 = *(const uint4*)(g_ + (size_t)32 * 3072); nk1 = *(const uint4*)(g_ + (size_t)32 * 3072 + 1024); \
  }
  if (bid_() < NB * 8 * NCH) GI_LOAD(bid_());
  for (int item = bid_(); item < NB * 8 * NCH; item += gridDim.x) {
    const int cs = item % NCH, bh = item / NCH, h = bh & 7, b = bh >> 3;
    const int rowbase = b * LTOK + cs * 64;
    {
      const int row = tid >> 4, c8 = (tid & 15) * 8;
      *(uint4*)(sQ + row * 136 + c8) = nq0; *(uint4*)(sK + row * 136 + c8) = nk0;
      *(uint4*)(sQ + (row + 32) * 136 + c8) = nq1; *(uint4*)(sK + (row + 32) * 136 + c8) = nk1;
    }
    if (item + (int)gridDim.x < NB * 8 * NCH) GI_LOAD(item + (int)gridDim.x);
    if (w < 2) {
      const int d = w, j = lane, jj = d ? 63 - j : j;
      const float* ab = AB + (size_t)(rowbase + jj) * 32;
      float g = -__expf(a_log[d * 8 + h]) * softplusf_(ab[d * 8 + h] + dtb[d * 8 + h]);
      float bt = sigmoidf_(ab[16 + d * 8 + h]);
      float v = g;
#pragma unroll
      for (int o = 1; o < 64; o <<= 1) { float t = __shfl_up(v, o); if (lane >= o) v += t; }
      sgc[d * 64 + j] = v; sbt[d * 64 + j] = bt;
      size_t o = ((size_t)((d * 4 + b) * 8 + h)) * LTOK + ndir_of(cs, d) * 64 + j;
      GC[o] = v; BT[o] = bt;
    }
    LDS_BARRIER();
    {
      const int which = w >> 2, mt = (w >> 1) & 1, nt = w & 1;
      const bfr* Aop = which ? sQ : sK;
      f32x16 acc;
#pragma unroll
      for (int e = 0; e < 16; ++e) acc[e] = 0.f;
#pragma unroll
      for (int ks = 0; ks < 8; ++ks) {
        bf16x8 a = *(const bf16x8*)(Aop + (mt * 32 + l31) * 136 + ks * 16 + hh * 8);
        bf16x8 bb = *(const bf16x8*)(sK + (nt * 32 + l31) * 136 + ks * 16 + hh * 8);
        acc = MFMA32(a, bb, acc);
      }
      float* dst = which ? sQK : sKK;
#pragma unroll
      for (int reg = 0; reg < 16; ++reg) dst[(mt * 32 + crow(reg, hh)) * 65 + nt * 32 + l31] = acc[reg];
      bfr* kt = KT + ((size_t)(rowbase >> 6) * 8 + h) * 8192;
      int tx3 = tid; asm volatile("" : "+v"(tx3));
#pragma unroll
      for (int i = 0; i < 2; ++i) {
        int cc = tx3 + 512 * i; int dk = cc >> 3, p8 = (cc & 7) * 8;
        unsigned short v[8];
#pragma unroll
        for (int e = 0; e < 8; ++e) v[e] = sK[(p8 + e) * 136 + dk];
        *(uint4*)(kt + dk * 64 + p8) = make_uint4(v[0] | ((unsigned)v[1] << 16), v[2] | ((unsigned)v[3] << 16), v[4] | ((unsigned)v[5] << 16), v[6] | ((unsigned)v[7] << 16));
      }
    }
    LDS_BARRIER();
    int tx1 = tid; asm volatile("" : "+v"(tx1));
#pragma unroll
    for (int i = 0; i < 16; ++i) {
      int e = tx1 + 512 * i; int d = e >> 12, ii = (e >> 6) & 63, jj = e & 63;
      int si = d ? 63 - ii : ii, sj = d ? 63 - jj : jj;
      float v = 0.f;
      if (jj < ii) v = sbt[d * 64 + ii] * sKK[si * 65 + sj] * __expf(sgc[d * 64 + ii] - sgc[d * 64 + jj]);
      sL[e] = v;
    }
    LDS_BARRIER();
    if (w < 2) {
      const int d = w, c = lane;
      const float* Ld = sL + d * 4096;
      float Tc[64];
#pragma unroll
      for (int i = 0; i < 64; ++i) Tc[i] = 0.f;
#pragma unroll
      for (int i = 0; i < 64; ++i) {
        float s0 = (i == c) ? 1.f : 0.f, s1 = 0.f, s2 = 0.f, s3 = 0.f;
#pragma unroll
        for (int j4 = 0; j4 < (i + 3) / 4; ++j4) {
          float4 l = *(const float4*)(Ld + i * 64 + j4 * 4);
          s0 -= l.x * Tc[4 * j4]; s1 -= l.y * Tc[4 * j4 + 1]; s2 -= l.z * Tc[4 * j4 + 2]; s3 -= l.w * Tc[4 * j4 + 3];
        }
        Tc[i] = (s0 + s1) + (s2 + s3);
        asm volatile("" ::: "memory");
      }
      float* Td = sTm + d * 4096;
#pragma unroll
      for (int i = 0; i < 64; ++i) Td[i * 64 + c] = Tc[i];
    }
    LDS_BARRIER();
    int tx2 = tid; asm volatile("" : "+v"(tx2));
#pragma unroll
    for (int i = 0; i < 2; ++i) {
      int cc = tx2 + 512 * i; int d = cc >> 9, i_ = (cc >> 3) & 63, j8 = (cc & 7) * 8;
      bfr* rec = REC + (((size_t)((d * 4 + b) * 8 + h)) * NCH + ndir_of(cs, d)) * 8192;
      const float* Td = sTm + d * 4096 + i_ * 64 + j8;
      *(uint4*)(rec + i_ * 64 + j8) = make_uint4(pack2(Td[0], Td[1]), pack2(Td[2], Td[3]), pack2(Td[4], Td[5]), pack2(Td[6], Td[7]));
      const int si = d ? 63 - i_ : i_;
      const float gci = sgc[d * 64 + i_];
      float aq[8];
#pragma unroll
      for (int e = 0; e < 8; ++e) {
        int j = j8 + e; int sj = d ? 63 - j : j;
        float v = sQK[si * 65 + sj] * __expf(gci - sgc[d * 64 + j]);
        aq[e] = (j <= i_) ? v : 0.f;
      }
      *(uint4*)(rec + 4096 + i_ * 64 + j8) = make_uint4(pack2(aq[0], aq[1]), pack2(aq[2], aq[3]), pack2(aq[4], aq[5]), pack2(aq[6], aq[7]));
    }
    LDS_BARRIER();
  }
}

struct ScanArgs {
  const bfr* q0; const bfr* q1; int qld0, qld1;
  const bfr* k0; int kld;
  const bfr* kt0; const bfr* kt1;
  const bfr* v; int vld;
  const bfr* m;
  const float* gc; const float* bt;
  const float* dlb;
  bfr* o0; bfr* o1; int old0, old1;
};

DI uint4 rev8(uint4 u) {
  uint4 r;
  r.x = (u.w >> 16) | (u.w << 16); r.y = (u.z >> 16) | (u.z << 16); r.z = (u.y >> 16) | (u.y << 16); r.w = (u.x >> 16) | (u.x << 16);
  return r;
}

template <bool GDN>
DI void phase_scan(const ScanArgs& a, char* lds) {
  bfr* sS = (bfr*)lds;
  bfr* sKb = sS + 128 * 136;
  bfr* sQd = sKb + 64 * 136;
  bfr* sKd = sQd + 64 * 136;
  bfr* sR = sKd + 128 * 72;
  bfr* sVn = sR + 128 * 72;
  bfr* sT = sVn + 128 * 72;
  bfr* sA = sT + 64 * 72;
  float* sdl = (float*)(sA + 64 * 72);
  const int tid = tid_(), lane = tid & 63, w = tid >> 6, l31 = lane & 31, hh = lane >> 5;
  for (int item = bid_(); item < 64; item += gridDim.x) {
    const int d = item >> 5, b = (item >> 3) & 3, h = item & 7;
    const int seq = (d * 4 + b) * 8 + h;
    const bfr* qp = (d ? a.q1 + 0 : a.q0 + 0) + h * 128; const int qld = d ? a.qld1 + 0 : a.qld0 + 0;
    const bfr* kp = a.k0 + h * 128; const int kld = a.kld;
    const bfr* ktp = (d ? a.kt1 + 0 : a.kt0 + 0);
    bfr* op = (d ? a.o1 + 0 : a.o0 + 0) + h * 128; const int old = d ? a.old1 + 0 : a.old0 + 0;
    f32x16 accS[2];
#pragma unroll
    for (int t = 0; t < 2; ++t)
#pragma unroll
      for (int e = 0; e < 16; ++e) accS[t][e] = 0.f;
    for (int i = tid; i < 128 * 136 / 2; i += NTHR) ((unsigned*)sS)[i] = 0u;
    uint4 pq0, pq1, pk0, pk1, pv0, pv1, pkt0, pkt1, pm0, pm1;
    float4 pg0, pg1;
    float pgc0 = 0.f, pgc1 = 0.f, pbt0 = 0.f, pbt1 = 0.f, pgl = 0.f, pdl = 0.f;
    const int jj0 = tid >> 4, c8 = (tid & 15) * 8;
    const int dk0 = tid >> 3, p8 = (tid & 7) * 8;
#define PF1(i, n_)                                                                                              \
      {                                                                                                     \
        const int jj = jj0 + 32 * i;                                                                        \
        pq##i = *(const uint4*)(qp + (rb_ + jj) * qld + c8);                                                \
        pkt##i = *(const uint4*)(ktp + tb_ + (dk0 + 64 * i) * 64 + p8);                                     \
        if (GDN) {                                                                                          \
          pk##i = *(const uint4*)(kp + (rb_ + jj) * kld + c8);                                              \
          pv##i = *(const uint4*)(a.v + (rb_ + jj) * a.vld + h * 128 + c8);                                 \
          const int j = d ? 63 - jj : jj; pgc##i = a.gc[(size_t)seq * LTOK + (n_) * 64 + j]; pbt##i = a.bt[(size_t)seq * LTOK + (n_) * 64 + j]; \
        } else {                                                                                            \
          pv##i = *(const uint4*)(a.v + tb_ + (dk0 + 64 * i) * 64 + p8);                                    \
        }                                                                                                   \
      }
#define PREFETCH(n_)                                                                                        \
    {                                                                                                       \
      const int cs_ = ndir_of((n_), d);                                                                     \
      const size_t rb_ = (size_t)b * LTOK + cs_ * 64;                                                       \
      const size_t tb_ = ((rb_ >> 6) * 8 + h) * 8192;                                                       \
      PF1(0, n_) PF1(1, n_)                                                                                         \
      if (GDN) {                                                                                            \
        const bfr* rec_ = a.m + ((size_t)seq * NCH + (n_)) * 8192;                                          \
        pm0 = *(const uint4*)(rec_ + tid * 8); pm1 = *(const uint4*)(rec_ + 4096 + tid * 8);               \
        const float* g_ = a.gc + (size_t)seq * LTOK + (n_) * 64;                                            \
        pgl = g_[63];                                                                                       \
        const int jb_ = d ? 56 - p8 : p8;                                                                   \
        pg0 = *(const float4*)(g_ + jb_); pg1 = *(const float4*)(g_ + jb_ + 4);                             \
      } else {                                                                                              \
        pm1 = *(const uint4*)(a.m + ((size_t)seq * NCH + (n_)) * 4096 + tid * 8);                           \
        if (tid < 128) pdl = a.dlb[((size_t)seq * NCH + (n_)) * 128 + tid];                                 \
      }                                                                                                     \
    }
    PREFETCH(0);
    for (int n = 0; n < NCH; ++n) {
      const int cs = ndir_of(n, d);
      const size_t rowbase = (size_t)b * LTOK + cs * 64;
      float dl_scalar = 1.f;
      {
        int jjx = jj0; asm volatile("" : "+v"(jjx));
#define FILLA(i) {           const int jj = jjx + 32 * i; const int j = d ? 63 - jj : jj; \
          if (GDN) { \
            const float eg = __expf(pgc##i); const float qs = eg, kbs = -pbt##i * eg, vs = pbt##i; \
            unsigned uq[4] = {pq##i.x, pq##i.y, pq##i.z, pq##i.w}; \
            unsigned uk[4] = {pk##i.x, pk##i.y, pk##i.z, pk##i.w}; \
            unsigned uv[4] = {pv##i.x, pv##i.y, pv##i.z, pv##i.w}; \
            unsigned oq[4], ok[4], ov[4]; \
_Pragma("unroll") \
            for (int e = 0; e < 4; ++e) { \
              oq[e] = pack2(lo2f(uq[e]) * qs, hi2f(uq[e]) * qs); \
              ok[e] = pack2(lo2f(uk[e]) * kbs, hi2f(uk[e]) * kbs); \
              ov[e] = pack2(lo2f(uv[e]) * vs, hi2f(uv[e]) * vs); \
            } \
            *(uint4*)(sQd + j * 136 + c8) = make_uint4(oq[0], oq[1], oq[2], oq[3]); \
            *(uint4*)(sKb + j * 136 + c8) = make_uint4(ok[0], ok[1], ok[2], ok[3]); \
            *(uint4*)(sVn + j * 136 + c8) = make_uint4(ov[0], ov[1], ov[2], ov[3]); \
          } else { \
            *(uint4*)(sQd + j * 136 + c8) = pq##i; \
          } \
         }
        FILLA(0) FILLA(1)
#undef FILLA
        int dkx = dk0; asm volatile("" : "+v"(dkx));
        const int pj = d ? 56 - p8 : p8;
        float ks8[8];
        if (GDN) {
          float g8[8] = {pg0.x, pg0.y, pg0.z, pg0.w, pg1.x, pg1.y, pg1.z, pg1.w};
#pragma unroll
          for (int e = 0; e < 8; ++e) ks8[e] = __expf(pgl - g8[e]);
        }
#define FILLB(i) {           uint4 kv = d ? rev8(pkt##i) : pkt##i; \
          if (GDN) { \
            unsigned uk[4] = {kv.x, kv.y, kv.z, kv.w}; \
            kv = make_uint4(pack2(lo2f(uk[0]) * ks8[0], hi2f(uk[0]) * ks8[1]), pack2(lo2f(uk[1]) * ks8[2], hi2f(uk[1]) * ks8[3]), \
                            pack2(lo2f(uk[2]) * ks8[4], hi2f(uk[2]) * ks8[5]), pack2(lo2f(uk[3]) * ks8[6], hi2f(uk[3]) * ks8[7])); \
          } \
          *(uint4*)(sKd + (dkx + 64 * i) * 72 + pj) = kv; \
          if (!GDN) *(uint4*)(sVn + (dkx + 64 * i) * 72 + pj) = d ? rev8(pv##i) : pv##i; \
         }
        FILLB(0) FILLB(1)
#undef FILLB
        if (GDN) *(uint4*)(sT + (tid >> 3) * 72 + (tid & 7) * 8) = pm0;
        *(uint4*)(sA + (tid >> 3) * 72 + (tid & 7) * 8) = pm1;
        if (GDN) dl_scalar = __expf(pgl);
        else if (tid < 128) sdl[tid] = pdl;
      }
      if (n + 1 < NCH) PREFETCH(n + 1);
      LDS_BARRIER();
      const int mt1 = w >> 2, nt1 = w & 3;
      if (GDN) {
        f32x16 acc, acc2;
#pragma unroll
        for (int e = 0; e < 16; ++e) { acc[e] = 0.f; acc2[e] = 0.f; }
#pragma unroll
        for (int ks = 0; ks < 8; ks += 2) {
          bf16x8 af = *(const bf16x8*)(sKb + (mt1 * 32 + l31) * 136 + ks * 16 + hh * 8);
          bf16x8 bg = *(const bf16x8*)(sS + (nt1 * 32 + l31) * 136 + ks * 16 + hh * 8);
          bf16x8 af2 = *(const bf16x8*)(sKb + (mt1 * 32 + l31) * 136 + (ks + 1) * 16 + hh * 8);
          bf16x8 bg2 = *(const bf16x8*)(sS + (nt1 * 32 + l31) * 136 + (ks + 1) * 16 + hh * 8);
          acc = MFMA32(af, bg, acc);
          acc2 = MFMA32(af2, bg2, acc2);
        }
#pragma unroll
        for (int e = 0; e < 16; ++e) acc[e] += acc2[e];
#pragma unroll
        for (int g = 0; g < 4; ++g) {
          const int pos = mt1 * 32 + 8 * g + 4 * hh;
          const bfr* vp_ = sVn + pos * 136 + nt1 * 32 + l31;
          uint2 o;
          o.x = pack2(bf2f(vp_[0]) + acc[4 * g], bf2f(vp_[136]) + acc[4 * g + 1]);
          o.y = pack2(bf2f(vp_[272]) + acc[4 * g + 2], bf2f(vp_[408]) + acc[4 * g + 3]);
          *(uint2*)(sR + (nt1 * 32 + l31) * 72 + pos) = o;
        }
        LDS_BARRIER();
#pragma unroll
        for (int e = 0; e < 16; ++e) { acc[e] = 0.f; acc2[e] = 0.f; }
#pragma unroll
        for (int ks = 0; ks < 4; ks += 2) {
          bf16x8 af = *(const bf16x8*)(sT + (mt1 * 32 + l31) * 72 + ks * 16 + hh * 8);
          bf16x8 bg = *(const bf16x8*)(sR + (nt1 * 32 + l31) * 72 + ks * 16 + hh * 8);
          bf16x8 af2 = *(const bf16x8*)(sT + (mt1 * 32 + l31) * 72 + (ks + 1) * 16 + hh * 8);
          bf16x8 bg2 = *(const bf16x8*)(sR + (nt1 * 32 + l31) * 72 + (ks + 1) * 16 + hh * 8);
          acc = MFMA32(af, bg, acc);
          acc2 = MFMA32(af2, bg2, acc2);
        }
#pragma unroll
        for (int e = 0; e < 16; ++e) acc[e] += acc2[e];
#pragma unroll
        for (int g = 0; g < 4; ++g) {
          uint2 o; o.x = pack2(acc[4 * g], acc[4 * g + 1]); o.y = pack2(acc[4 * g + 2], acc[4 * g + 3]);
          *(uint2*)(sVn + (nt1 * 32 + l31) * 72 + mt1 * 32 + 8 * g + 4 * hh) = o;
        }
        LDS_BARRIER();
      }
      {
        f32x16 acc, acc2, acc3;
#pragma unroll
        for (int e = 0; e < 16; ++e) { acc[e] = 0.f; acc2[e] = 0.f; acc3[e] = 0.f; }
#pragma unroll
        for (int ks = 0; ks < 4; ++ks) {
          bf16x8 af = *(const bf16x8*)(sQd + (mt1 * 32 + l31) * 136 + ks * 16 + hh * 8);
          bf16x8 bg = *(const bf16x8*)(sS + (nt1 * 32 + l31) * 136 + ks * 16 + hh * 8);
          bf16x8 af2 = *(const bf16x8*)(sQd + (mt1 * 32 + l31) * 136 + (ks + 4) * 16 + hh * 8);
          bf16x8 bg2 = *(const bf16x8*)(sS + (nt1 * 32 + l31) * 136 + (ks + 4) * 16 + hh * 8);
          bf16x8 af3 = *(const bf16x8*)(sA + (mt1 * 32 + l31) * 72 + ks * 16 + hh * 8);
          bf16x8 bg3 = *(const bf16x8*)(sVn + (nt1 * 32 + l31) * 72 + ks * 16 + hh * 8);
          acc = MFMA32(af, bg, acc);
          acc2 = MFMA32(af2, bg2, acc2);
          acc3 = MFMA32(af3, bg3, acc3);
        }
#pragma unroll
        for (int e = 0; e < 16; ++e) acc[e] += acc2[e] + acc3[e];
#pragma unroll
        for (int reg = 0; reg < 16; ++reg) sR[(mt1 * 32 + crow(reg, hh)) * 136 + nt1 * 32 + l31] = f2bf(acc[reg]);
      }
      {
        const int mt = w >> 1;
#pragma unroll
        for (int t = 0; t < 2; ++t)
#pragma unroll
          for (int reg = 0; reg < 16; ++reg) {
            float dl = GDN ? dl_scalar : sdl[mt * 32 + crow(reg, hh)];
            accS[t][reg] *= dl;
          }
#pragma unroll
        for (int ks = 0; ks < 4; ++ks) {
          bf16x8 af = *(const bf16x8*)(sKd + (mt * 32 + l31) * 72 + ks * 16 + hh * 8);
          bf16x8 bg0 = *(const bf16x8*)(sVn + ((2 * (w & 1)) * 32 + l31) * 72 + ks * 16 + hh * 8);
          bf16x8 bg1 = *(const bf16x8*)(sVn + ((2 * (w & 1) + 1) * 32 + l31) * 72 + ks * 16 + hh * 8);
          accS[0] = MFMA32(af, bg0, accS[0]);
          accS[1] = MFMA32(af, bg1, accS[1]);
        }
        LDS_BARRIER();
#pragma unroll
        for (int t = 0; t < 2; ++t) {
          const int nt = 2 * (w & 1) + t;
#pragma unroll
          for (int g = 0; g < 4; ++g) {
            uint2 o; o.x = pack2(accS[t][4 * g], accS[t][4 * g + 1]); o.y = pack2(accS[t][4 * g + 2], accS[t][4 * g + 3]);
            *(uint2*)(sS + (nt * 32 + l31) * 136 + mt * 32 + 8 * g + 4 * hh) = o;
          }
        }
        {
          int tx = tid; asm volatile("" : "+v"(tx));
#pragma unroll
          for (int i = 0; i < 2; ++i) {
            const int j = (tx >> 4) + 32 * i, c8o = (tx & 15) * 8;
            const uint4 ov = *(const uint4*)(sR + j * 136 + c8o);
            if (GDN) *(uint4*)((bfr*)a.m + ((size_t)seq * NCH + n) * 8192 + j * 128 + c8o) = ov;
            else { const int jj = d ? 63 - j : j; *(uint4*)(op + (rowbase + jj) * old + c8o) = ov; }
          }
        }
        if (GDN) asm volatile("" : "+v"(pgl), "+v"(pgc0), "+v"(pgc1), "+v"(pbt0), "+v"(pbt1), "+v"(pg0.x), "+v"(pg0.y), "+v"(pg0.z), "+v"(pg0.w), "+v"(pg1.x), "+v"(pg1.y), "+v"(pg1.z), "+v"(pg1.w));
        else asm volatile("" : "+v"(pdl));
      }
    }
#undef PREFETCH
#undef PF1
    LDS_BARRIER();
  }
}

template <bool REC>
DI void phase_headnorm(const bfr* of, const bfr* ob, const bfr* z, const float* nw, bfr* Y) {
  const int lane = tid_() & 63, w = tid_() >> 6;
  const int c = lane * 16;
  float wv[16];
#pragma unroll
  for (int e = 0; e < 16; ++e) wv[e] = nw[(c + e) & 127];
  const int stride = gridDim.x * 8;
  for (int r0 = bid_() * 8 + w; r0 < T; r0 += 2 * stride) {
    uint4 f0[2], f1[2], b0[2], b1[2], z0[2], z1[2];
#pragma unroll
    for (int k = 0; k < 2; ++k) {
      const int r = r0 + k * stride < T ? r0 + k * stride : r0;
      const bfr *pf, *pb;
      if (REC) {
        const int b = r / LTOK, q = r - b * LTOK, cs = q >> 6, jj = q & 63, h = lane >> 3;
        pf = of + (((size_t)(b * 8 + h)) * NCH + cs) * 8192 + jj * 128 + (c & 127);
        pb = of + (((size_t)((4 + b) * 8 + h)) * NCH + ndir_of(cs, 1)) * 8192 + (63 - jj) * 128 + (c & 127);
      } else {
        pf = of + (size_t)r * 1024 + c; pb = ob + (size_t)r * 1024 + c;
      }
      f0[k] = *(const uint4*)pf; f1[k] = *(const uint4*)(pf + 8);
      b0[k] = *(const uint4*)pb; b1[k] = *(const uint4*)(pb + 8);
      z0[k] = *(const uint4*)(z + (size_t)r * 1024 + c); z1[k] = *(const uint4*)(z + (size_t)r * 1024 + c + 8);
    }
#pragma unroll
    for (int k = 0; k < 2; ++k) {
      const int r = r0 + k * stride;
      unsigned fu[8] = {f0[k].x, f0[k].y, f0[k].z, f0[k].w, f1[k].x, f1[k].y, f1[k].z, f1[k].w};
      unsigned bu[8] = {b0[k].x, b0[k].y, b0[k].z, b0[k].w, b1[k].x, b1[k].y, b1[k].z, b1[k].w};
      unsigned zu[8] = {z0[k].x, z0[k].y, z0[k].z, z0[k].w, z1[k].x, z1[k].y, z1[k].z, z1[k].w};
      float o[16]; float ss = 0;
#pragma unroll
      for (int e = 0; e < 8; ++e) {
        o[2 * e] = lo2f(fu[e]) + lo2f(bu[e]); o[2 * e + 1] = hi2f(fu[e]) + hi2f(bu[e]);
        ss += o[2 * e] * o[2 * e] + o[2 * e + 1] * o[2 * e + 1];
      }
      ss += __shfl_xor(ss, 1); ss += __shfl_xor(ss, 2); ss += __shfl_xor(ss, 4);
      float rstd = rsqrtf(ss * (1.f / 128.f) + 1e-6f);
      unsigned ou[8];
#pragma unroll
      for (int e = 0; e < 8; ++e) {
        float y0 = o[2 * e] * rstd * wv[2 * e] * siluf_(lo2f(zu[e]));
        float y1 = o[2 * e + 1] * rstd * wv[2 * e + 1] * siluf_(hi2f(zu[e]));
        ou[e] = pack2(y0, y1);
      }
      if (r < T) {
        *(uint4*)(Y + (size_t)r * 1024 + c) = make_uint4(ou[0], ou[1], ou[2], ou[3]);
        *(uint4*)(Y + (size_t)r * 1024 + c + 8) = make_uint4(ou[4], ou[5], ou[6], ou[7]);
      }
    }
  }
}

DI int lru_row(int b, int d, int u) { int q = (u < CTX) ? (d ? CTX - 1 - u : u) : (d ? (LTOK - 1 + CTX) - u : u); return b * LTOK + q; }

DI void phase_lru_scan(const bfr* LA, bfr* BV, char* lds) {
  float* sSeg = (float*)lds;
  const int lane = tid_() & 63, w = tid_() >> 6;
  const int seg = w * 2 + (lane >> 5), cl = lane & 31;
  constexpr int SEGL = LTOK / 16;
  constexpr int BS = 16;
  for (int item = bid_(); item < NB * 2 * 32; item += gridDim.x) {
    const int cg_ = item & 31, d = (item >> 5) & 1, b = item >> 6;
    const int ch = cg_ * 32 + cl;
    const size_t base = (size_t)d * T * 1024 + ch;
    float h = 0.f, sl = 0.f;
    for (int u0 = seg * SEGL; u0 < (seg + 1) * SEGL; u0 += BS) {
      const long o0 = (long)base + (long)lru_row(b, d, u0) * 1024;
      const long st = d ? -1024 : 1024;
      bfr la[BS], bv[BS];
#pragma unroll
      for (int e = 0; e < BS; ++e) { la[e] = LA[o0 + e * st]; bv[e] = BV[o0 + e * st]; }
#pragma unroll
      for (int e = 0; e < BS; ++e) { float l = bf2f(la[e]); h = __expf(l) * h + bf2f(bv[e]); sl += l; }
    }
    sSeg[(seg * 2) * 32 + cl] = sl; sSeg[(seg * 2 + 1) * 32 + cl] = h;
    LDS_BARRIER();
    float h0 = 0.f;
    for (int s_ = 0; s_ < seg; ++s_) h0 = __expf(sSeg[(s_ * 2) * 32 + cl]) * h0 + sSeg[(s_ * 2 + 1) * 32 + cl];
    h = h0;
    for (int u0 = seg * SEGL; u0 < (seg + 1) * SEGL; u0 += BS) {
      const long o0 = (long)base + (long)lru_row(b, d, u0) * 1024;
      const long st = d ? -1024 : 1024;
      bfr la[BS], bv[BS];
#pragma unroll
      for (int e = 0; e < BS; ++e) { la[e] = LA[o0 + e * st]; bv[e] = BV[o0 + e * st]; }
#pragma unroll
      for (int e = 0; e < BS; ++e) { h = __expf(bf2f(la[e])) * h + bf2f(bv[e]); bv[e] = f2bf(h); }
#pragma unroll
      for (int e = 0; e < BS; ++e) BV[o0 + e * st] = bv[e];
    }
    LDS_BARRIER();
  }
}

DI void phase_lru_combine(const bfr* P, const bfr* BV, bfr* Y) {
  const size_t total = (size_t)T * 128;
  for (size_t i = (size_t)bid_() * NTHR + tid_(); i < total; i += (size_t)gridDim.x * NTHR) {
    size_t r = i >> 7; int c = (int)(i & 127) * 8;
    uint4 g = *(const uint4*)(P + r * 2048 + c);
    uint4 f = *(const uint4*)(BV + r * 1024 + c);
    uint4 bk = *(const uint4*)(BV + ((size_t)T + r) * 1024 + c);
    unsigned gu[4] = {g.x, g.y, g.z, g.w}, fu[4] = {f.x, f.y, f.z, f.w}, bu[4] = {bk.x, bk.y, bk.z, bk.w}, ou[4];
#pragma unroll
    for (int e = 0; e < 4; ++e) {
      float y0 = geluf_(lo2f(gu[e])) * (lo2f(fu[e]) + lo2f(bu[e]));
      float y1 = geluf_(hi2f(gu[e])) * (hi2f(fu[e]) + hi2f(bu[e]));
      ou[e] = pack2(y0, y1);
    }
    *(uint4*)(Y + r * 1024 + c) = make_uint4(ou[0], ou[1], ou[2], ou[3]);
  }
}

template <int D_>
DI void hg_column(uint4* fr, const float lb, const bfr* sQs, bfr* sQe, bfr* sKe, bfr* qdst, int qdld, int c, float& dl_out) {
  float lf[64];
  float gc = 0.f, ref = 0.f;
#pragma unroll
  for (int j = 0; j < 64; ++j) {
    const int jj = D_ ? 63 - j : j;
    const unsigned u = ((const unsigned*)fr)[jj >> 1];
    const float raw = (jj & 1) ? hi2f(u) : lo2f(u);
    const float f = lb + (1.f - lb) * sigmoidf_(raw);
    lf[j] = __logf(f);
    gc += lf[j];
    if (j == 32) ref = gc;
  }
  const float glast = gc;
  gc = 0.f;
  unsigned short kd[64];
#pragma unroll
  for (int j = 0; j < 64; ++j) {
    const int jj = D_ ? 63 - j : j;
    gc += lf[j];
    const float kf = 1.f - __expf(lf[j]);
    const float qs = bf2f(sQs[jj * 128 + c]);
    sQe[(D_ * 64 + j) * 136 + c] = f2bf(qs * __expf(gc - ref));
    sKe[(D_ * 64 + j) * 136 + c] = f2bf(kf * __expf(ref - gc));
    kd[jj] = f2bf(kf * __expf(glast - gc));
    qdst[(size_t)jj * qdld] = f2bf(qs * __expf(gc));
  }
#pragma unroll
  for (int i = 0; i < 8; ++i)
    fr[i] = make_uint4(kd[8 * i] | ((unsigned)kd[8 * i + 1] << 16), kd[8 * i + 2] | ((unsigned)kd[8 * i + 3] << 16),
                       kd[8 * i + 4] | ((unsigned)kd[8 * i + 5] << 16), kd[8 * i + 6] | ((unsigned)kd[8 * i + 7] << 16));
  dl_out = __expf(glast);
}

DI void phase_hg_intra(const Params& p, int layer, char* lds) {
  bfr* sQe = (bfr*)lds;
  bfr* sKe = sQe + 2 * 64 * 136;
  bfr* sQs = sKe + 2 * 64 * 136;
  bfr* Q = (bfr*)(p.ws + UB);
  bfr* QD1 = (bfr*)p.ws;
  bfr* SC = (bfr*)(p.ws + 6 * UB);
  float* DLB = (float*)(p.ws + OFF_AB);
  const int tid = tid_(), lane = tid & 63, w = tid >> 6, l31 = lane & 31, hh = lane >> 5;
  for (int item = bid_(); item < NB * 8 * NCH; item += gridDim.x) {
    const int cs = item % NCH, bh = item / NCH, h = bh & 7, b = bh >> 3;
    const size_t rowbase = (size_t)b * LTOK + cs * 64;
#pragma unroll
    for (int i = 0; i < 2; ++i) {
      int cc = tid + 512 * i; int row = cc >> 4, c8 = (cc & 15) * 8;
      uint4 u = *(const uint4*)(Q + (rowbase + row) * 1024 + h * 128 + c8);
      unsigned uu[4] = {u.x, u.y, u.z, u.w}, oo[4];
#pragma unroll
      for (int e = 0; e < 4; ++e) oo[e] = pack2(siluf_(lo2f(uu[e])), siluf_(hi2f(uu[e])));
      *(uint4*)(sQs + row * 128 + c8) = make_uint4(oo[0], oo[1], oo[2], oo[3]);
    }
    LDS_BARRIER();
    if (tid < 256) {
      const int d = tid >> 7, c = tid & 127, hc = h * 128 + c;
      float x0 = p.hg_lb_logits[hc], x1 = p.hg_lb_logits[1024 + hc], x2 = p.hg_lb_logits[2048 + hc], x3 = p.hg_lb_logits[3072 + hc];
      float mx = fmaxf(fmaxf(x0, x1), fmaxf(x2, x3));
      float e0 = expf(x0 - mx), e1 = expf(x1 - mx), e2 = expf(x2 - mx), e3 = expf(x3 - mx);
      float inv = 1.f / (e0 + e1 + e2 + e3);
      float lb = 0.f;
      if (layer >= 1) lb += e1 * inv;
      if (layer >= 2) lb += e2 * inv;
      if (layer >= 3) lb += e3 * inv;
      bfr* fcol = (bfr*)(p.ws + (size_t)(2 + d) * UB) + (((rowbase >> 6) * 8 + h) * 8192) + c * 64;
      uint4 fr[8];
#pragma unroll
      for (int i = 0; i < 8; ++i) fr[i] = *(const uint4*)(fcol + 8 * i);
      float dl;
      if (d == 0) hg_column<0>(fr, lb, sQs, sQe, sKe, Q + rowbase * 1024 + hc, 1024, c, dl);
      else hg_column<1>(fr, lb, sQs, sQe, sKe, QD1 + rowbase * 1024 + hc, 1024, c, dl);
#pragma unroll
      for (int i = 0; i < 8; ++i) *(uint4*)(fcol + 8 * i) = fr[i];
      const int seq = (d * 4 + b) * 8 + h;
      DLB[((size_t)seq * NCH + ndir_of(cs, d)) * 128 + c] = dl;
    }
    LDS_BARRIER();
    {
      const int d = w >> 2, mt = (w >> 1) & 1, nt = w & 1;
      f32x16 acc;
#pragma unroll
      for (int e = 0; e < 16; ++e) acc[e] = 0.f;
#pragma unroll
      for (int ks = 0; ks < 8; ++ks) {
        bf16x8 af = *(const bf16x8*)(sQe + (d * 64 + mt * 32 + l31) * 136 + ks * 16 + hh * 8);
        bf16x8 bg = *(const bf16x8*)(sKe + (d * 64 + nt * 32 + l31) * 136 + ks * 16 + hh * 8);
        acc = MFMA32(af, bg, acc);
      }
      const int seq = (d * 4 + b) * 8 + h;
      bfr* dst = SC + ((size_t)seq * NCH + ndir_of(cs, d)) * 4096;
#pragma unroll
      for (int reg = 0; reg < 16; ++reg) {
        int i_ = mt * 32 + crow(reg, hh), j_ = nt * 32 + l31;
        dst[i_ * 64 + j_] = (j_ <= i_) ? f2bf(acc[reg]) : (bfr)0;
      }
    }
    LDS_BARRIER();
  }
}

DI void phase_final(const Params& p) {
  const int lane = tid_() & 63, w = tid_() >> 6;
  const int stride = gridDim.x * 8;
  float4 wv[4];
#pragma unroll
  for (int i = 0; i < 4; ++i) wv[i] = *(const float4*)(p.norm_final + lane * 4 + 256 * i);
  for (int r0 = bid_() * 8 + w; r0 < NB * SEQ; r0 += 4 * stride) {
    float4 v[4][4];
#pragma unroll
    for (int k = 0; k < 4; ++k)
#pragma unroll
      for (int i = 0; i < 4; ++i) v[k][i] = *(const float4*)(p.out + (size_t)(r0 + k * stride) * DM + lane * 4 + 256 * i);
#pragma unroll
    for (int k = 0; k < 4; ++k) {
      float ss = 0;
#pragma unroll
      for (int i = 0; i < 4; ++i) ss += v[k][i].x * v[k][i].x + v[k][i].y * v[k][i].y + v[k][i].z * v[k][i].z + v[k][i].w * v[k][i].w;
#pragma unroll
      for (int o = 32; o > 0; o >>= 1) ss += __shfl_xor(ss, o);
      const float rstd = rsqrtf(ss * (1.f / 1024.f) + 1e-6f);
#pragma unroll
      for (int i = 0; i < 4; ++i) {
        float4 o; o.x = v[k][i].x * rstd * wv[i].x; o.y = v[k][i].y * rstd * wv[i].y; o.z = v[k][i].z * rstd * wv[i].z; o.w = v[k][i].w * rstd * wv[i].w;
        *(float4*)(p.out + (size_t)(r0 + k * stride) * DM + lane * 4 + 256 * i) = o;
      }
    }
  }
}

#define XB_TMO      128
#define XB_XCNT(j)  (256  + 64 * (j))
#define XB_XSUB(j)  (1280 + 64 * (j))
#define XB_XGEN(j)  (2304 + 64 * (j))
#define XB_TOP      3328
#define XB_TOPGEN   3392
#define XCD_BAR_WORDS 3456
#define XB_SPIN_CAP (1u << 18)
#define LAS __attribute__((address_space(3)))

__device__ __forceinline__ unsigned xb_ld(unsigned* p)              { return __hip_atomic_load(p, __ATOMIC_RELAXED, __HIP_MEMORY_SCOPE_AGENT); }
__device__ __forceinline__ unsigned xb_add(unsigned* p, unsigned v) { return __hip_atomic_fetch_add(p, v, __ATOMIC_RELAXED, __HIP_MEMORY_SCOPE_AGENT); }
__device__ __forceinline__ unsigned xb_xcc_id() { return (unsigned)__builtin_amdgcn_s_getreg((3 << 11) | 20) & 0xFu; }
#define XB_SPIN(cond, bar) do { unsigned _sp = 0; while (cond) { __builtin_amdgcn_s_sleep(1); \
    if ((++_sp & 255u) == 0u) { if (xb_ld(&(bar)[XB_TMO])) break; if (_sp > XB_SPIN_CAP) { atomicAdd(&(bar)[XB_TMO], 1u); break; } } } } while (0)

struct XcdBarrier {
    unsigned* bar; unsigned x;
    volatile LAS unsigned* st;
};

__device__ __forceinline__ XcdBarrier xcd_barrier_post(unsigned* bar, volatile LAS unsigned* st) {
    XcdBarrier b; b.bar = bar; b.x = xb_xcc_id(); b.st = st;
    if (threadIdx.x == 0) (void)xb_add(&bar[XB_XCNT(b.x)], 1u);
    return b;
}
__device__ __forceinline__ void xcd_barrier_complete(unsigned* bar, unsigned x, unsigned& nloc, unsigned& nx) {
    const unsigned G = gridDim.x * gridDim.y * gridDim.z;
    unsigned sum, cnt, mine, sp = 0u;
    for (;;) {
        sum = 0u; cnt = 0u; mine = 0u;
#pragma unroll
        for (unsigned j = 0; j < 16; ++j) { const unsigned c = xb_ld(&bar[XB_XCNT(j)]); sum += c; cnt += (c > 0u) ? 1u : 0u; mine = (j == x) ? c : mine; }
        if (sum == G) break;
        __builtin_amdgcn_s_sleep(1);
        if ((++sp & 255u) == 0u) { if (xb_ld(&bar[XB_TMO])) break; if (sp > XB_SPIN_CAP) { atomicAdd(&bar[XB_TMO], 1u); break; } }
    }
    nloc = mine > 0u ? mine : 1u; nx = cnt > 0u ? cnt : 1u;
}

__device__ __forceinline__ void xcd_barrier(const XcdBarrier& b) {
    asm volatile("s_waitcnt vmcnt(0)" ::: "memory");
    __syncthreads();
    if (threadIdx.x == 0) {
        unsigned* bar = b.bar;
        __builtin_amdgcn_s_waitcnt(0);
        unsigned nloc = b.st[0], nx = b.st[1];
        const unsigned old = xb_add(&bar[XB_XSUB(b.x)], 1u);
        const unsigned gen = old / nloc;
        if (old + 1u == (gen + 1u) * nloc) {
            __builtin_amdgcn_fence(__ATOMIC_RELEASE, "agent");
            asm volatile("s_waitcnt vmcnt(0)" ::: "memory");
            const unsigned og = xb_add(&bar[XB_TOP], 1u);
            const unsigned tg = og / nx;
            if (og + 1u == (tg + 1u) * nx) xb_add(&bar[XB_TOPGEN], 1u);
            else XB_SPIN(xb_ld(&bar[XB_TOPGEN]) == tg, bar);
            __builtin_amdgcn_fence(__ATOMIC_ACQUIRE, "agent");
            xb_add(&bar[XB_XGEN(b.x)], 1u);
            asm volatile("s_waitcnt vmcnt(0)" ::: "memory");
        } else {
            XB_SPIN(xb_ld(&bar[XB_XGEN(b.x)]) == gen, bar);
            __builtin_amdgcn_fence(__ATOMIC_ACQUIRE, "agent");
            asm volatile("s_waitcnt vmcnt(0)" ::: "memory");
        }
    }
    __syncthreads();
}


__global__ void __launch_bounds__(NTHR) fwd_megakernel(Params p) {
  extern __shared__ __attribute__((aligned(16))) char lds[];
  cg::grid_group grid = cg::this_grid();
  volatile LAS unsigned* xst = (volatile LAS unsigned*)(lds + 147456 + 256);
  if (threadIdx.x == 0) { xst[0] = 0u; xst[1] = 0u; xst[2] = 0u; xst[3] = 0u; }
  __syncthreads();
  (void)xcd_barrier_post((unsigned*)(p.ws + OFF_BAR), xst);
  int ph = 0;
  const int lo = p.ph_lo, hi = p.ph_hi;
#define PHASE(...) { if (ph >= lo && ph < hi) { __VA_ARGS__; if (ph + 1 < hi) { XcdBarrier xb_; xb_.bar = (unsigned*)(p.ws + OFF_BAR); xb_.x = xb_xcc_id(); xb_.st = (volatile LAS unsigned*)(lds + 147456 + 256); xcd_barrier(xb_); } } ++ph; }
  const float* MODB = (const float*)(p.ws + OFF_MOD);
  bfr* H = (bfr*)p.ws;
  const bfr* WB = (const bfr*)(p.ws + OFF_WB);
  { phase_mod(p, lds); phase_wprep(p, 0, lds, 5, (int)bid_() - 128, (int)gridDim.x - 128); grid.sync(); if (threadIdx.x == 0) { unsigned nl_, nx_; xcd_barrier_complete((unsigned*)(p.ws + OFF_BAR), xb_xcc_id(), nl_, nx_); xst[0] = nl_; xst[1] = nx_; } __syncthreads(); ++ph; }
#pragma unroll 1
  for (int layer = 0; layer < 4; ++layer) {
    const bool colmaj = (layer & 1) != 0;
    const bool first = layer == 0;
    const bool last = layer == 3;
    const int kind = layer % 3, jl = layer / 3;
    const float* MODL = MODB + (size_t)layer * 5 * 6144;
    PHASE({ phase_norm(p, layer, p.norm_mix + layer * 1024, 0, 1, colmaj, first); phase_wprep(p, layer, lds, first ? 2 : 2, bid_(), gridDim.x); });
    if (kind == 0) {
      PHASE({ EpiGdnIn e{WB + WB_IN, (bfr*)(p.ws + 3 * UB), (bfr*)(p.ws + 6 * UB), (float*)(p.ws + OFF_AB)};
              gemm_phase_glds16(H, 17, e, lds); });
      PHASE(phase_conv<0>((const bfr*)(p.ws + 3 * UB), 3072, 0, (bfr*)p.ws, 3072, p.gdn_conv + (size_t)jl * 4 * 3072, nullptr));
      PHASE(phase_gdn_intra(p, jl, lds));
      PHASE({ ScanArgs a;
              a.q0 = a.q1 = (const bfr*)p.ws; a.qld0 = a.qld1 = 3072;
              a.k0 = (const bfr*)p.ws + 1024; a.kld = 3072;
              a.kt0 = a.kt1 = (const bfr*)(p.ws + 5 * UB);
              a.v = (const bfr*)p.ws + 2048; a.vld = 3072;
              a.m = (const bfr*)(p.ws + 3 * UB); a.gc = (const float*)(p.ws + OFF_GC); a.bt = (const float*)(p.ws + OFF_BT); a.dlb = nullptr;
              a.o0 = a.o1 = nullptr; a.old0 = a.old1 = 0;
              phase_scan<true>(a, lds); });
      PHASE(phase_headnorm<true>((const bfr*)(p.ws + 3 * UB), nullptr, (const bfr*)(p.ws + 6 * UB), p.gdn_norm + jl * 128, (bfr*)p.ws));
      PHASE({ EpiResid e{WB + WB_OUT, &p, MODL + 2 * 1024, colmaj, first, 1024};
              gemm_phase_glds16((const bfr*)p.ws, 4, e, lds, 1024, 128, last); if (!last) gemm_phase<128>((const bfr*)p.ws, 1024, 1024, 8, e, lds, 256, 8); });
    } else if (kind == 1) {
      PHASE({ EpiPlain e{WB + WB_IN, (bfr*)(p.ws + UB), 2048, 1024};
              gemm_phase_glds16(H, 8, e, lds); });
      PHASE(phase_conv<1>((const bfr*)(p.ws + UB), 2048, 1024, (bfr*)p.ws, 1024, p.lru_conv_w + (size_t)jl * 4 * 1024, p.lru_conv_b + jl * 1024));
      PHASE({ EpiLruGate e{WB + WB_GATE, p.lru_b_r + jl * 2048, p.lru_b_i + jl * 2048,
                           p.lru_lambda + jl * 2048, (const bfr*)p.ws, (bfr*)(p.ws + 3 * UB), (bfr*)(p.ws + 5 * UB)};
              gemm_phase<256>((const bfr*)p.ws, 1024, 128, 32, e, lds); });
      PHASE(phase_lru_scan((const bfr*)(p.ws + 3 * UB), (bfr*)(p.ws + 5 * UB), lds));
      PHASE(phase_lru_combine((const bfr*)(p.ws + UB), (const bfr*)(p.ws + 5 * UB), (bfr*)p.ws));
      PHASE({ EpiResid e{WB + WB_OUT, &p, MODL + 2 * 1024, colmaj, first, 1024};
              gemm_phase_glds16((const bfr*)p.ws, 4, e, lds, 1024, 128, last); if (!last) gemm_phase<128>((const bfr*)p.ws, 1024, 1024, 8, e, lds, 256, 8); });
    } else {
      PHASE({ EpiHgIn e{WB + WB_IN, p.ws};
              gemm_phase_glds16(H, 20, e, lds); });
      PHASE(phase_hg_intra(p, layer, lds));
      PHASE({ ScanArgs a;
              a.q0 = (const bfr*)(p.ws + UB); a.q1 = (const bfr*)p.ws; a.qld0 = a.qld1 = 1024;
              a.k0 = nullptr; a.kld = 0;
              a.kt0 = (const bfr*)(p.ws + 2 * UB); a.kt1 = (const bfr*)(p.ws + 3 * UB);
              a.v = (const bfr*)(p.ws + 4 * UB); a.vld = 0;
              a.m = (const bfr*)(p.ws + 6 * UB); a.gc = nullptr; a.bt = nullptr; a.dlb = (const float*)(p.ws + OFF_AB);
              a.o0 = (bfr*)(p.ws + UB); a.o1 = (bfr*)p.ws; a.old0 = a.old1 = 1024;
              phase_scan<false>(a, lds); });
      PHASE(phase_headnorm<false>((const bfr*)(p.ws + UB), (const bfr*)p.ws, (const bfr*)(p.ws + 5 * UB), p.hg_norm + jl * 128, (bfr*)(p.ws + 6 * UB)));
      PHASE({ EpiResid e{WB + WB_OUT, &p, MODL + 2 * 1024, colmaj, first, 1024};
              gemm_phase_glds16((const bfr*)(p.ws + 6 * UB), 4, e, lds, 1024, 128, last); if (!last) gemm_phase<128>((const bfr*)(p.ws + 6 * UB), 1024, 1024, 8, e, lds, 256, 8); });
    }
    PHASE(phase_norm(p, layer, p.norm_ffn + layer * 1024, 3, 4, false, false));
    PHASE({ EpiFfnUp e{WB + WB_W1, (bfr*)(p.ws + UB)};
            gemm_phase_glds16(H, 22, e, lds, 1024, last ? 128 : 132, last); });
    PHASE({ EpiResid e{WB + WB_W2, &p, MODL + 5 * 1024, false, false, FFH};
            gemm_phase_glds16((const bfr*)(p.ws + UB), 4, e, lds, FFH, 128, last); if (!last) gemm_phase<128>((const bfr*)(p.ws + UB), FFH, FFH, 8, e, lds, 256, 8);
            if (!last) { const int b7 = bid_() & 7; phase_wprep(p, layer + 1, lds, 5, b7 >= 2 ? (bid_() >> 3) * 6 + (b7 - 2) : -1, (gridDim.x >> 3) * 6); } });
  }
  PHASE(phase_final(p));
#undef PHASE
}

constexpr int N_PHASES = 1 + 10 + 10 + 9 + 10 + 1;

extern "C" void kernel_launch(void* const* d_in, const int* in_sizes, int n_in, void* d_out, int out_size, void* d_ws,
                              size_t ws_size, hipStream_t stream) {
  static int grid_blocks = 0;
  if (!grid_blocks) {
    if (ws_size < WS_NEED) { fprintf(stderr, "kernel_launch: workspace too small: %zu < %zu\n", ws_size, (size_t)WS_NEED); grid_blocks = -1; return; }
    int dev = 0, cus = 0, per_cu = 0;
    hipGetDevice(&dev);
    hipDeviceGetAttribute(&cus, hipDeviceAttributeMultiprocessorCount, dev);
    if (hipFuncSetAttribute((const void*)fwd_megakernel, hipFuncAttributeMaxDynamicSharedMemorySize, LDS_BYTES) != hipSuccess) {
      fprintf(stderr, "kernel_launch: hipFuncSetAttribute failed\n"); grid_blocks = -1; return;
    }
    hipOccupancyMaxActiveBlocksPerMultiprocessor(&per_cu, (const void*)fwd_megakernel, NTHR, LDS_BYTES);
    if (per_cu < 1) { fprintf(stderr, "kernel_launch: occupancy query gave %d\n", per_cu); per_cu = 1; }
    if (per_cu > 1) per_cu = 1;
    grid_blocks = cus * per_cu;
    (void)hipGetLastError();
  }
  if (grid_blocks < 0) return;
  Params p{};
  const float** fp = (const float**)&p;
  for (int i = 0; i < 31; ++i) fp[i] = (const float*)d_in[i];
  p.out = (float*)d_out;
  p.ws = (char*)d_ws;
  hipMemsetAsync((char*)d_ws + OFF_BAR, 0, BAR_BYTES, stream);
#if MULTI_LAUNCH
  for (int ph = 0; ph < N_PHASES; ++ph) {
    p.ph_lo = ph; p.ph_hi = ph + 1;
    hipLaunchKernelGGL(fwd_megakernel, dim3(grid_blocks), dim3(NTHR), LDS_BYTES, stream, p);
  }
#else
  p.ph_lo = 0; p.ph_hi = N_PHASES;
  void* args[] = {&p};
  hipError_t e = hipLaunchCooperativeKernel((const void*)fwd_megakernel, dim3(grid_blocks), dim3(NTHR), args, LDS_BYTES, stream);
  if (e != hipSuccess) fprintf(stderr, "cooperative launch failed: %s (grid %d)\n", hipGetErrorString(e), grid_blocks);
#endif
}
```

```cpp
#include <hip/hip_runtime.h>
#include <hip/hip_cooperative_groups.h>
#include <cstdio>
#include <cstdint>
namespace cg = cooperative_groups;

#define DI __device__ __forceinline__
typedef __attribute__((ext_vector_type(8))) short bf16x8;
typedef __attribute__((ext_vector_type(16))) float f32x16;
typedef unsigned short bfr;
typedef __attribute__((ext_vector_type(4))) float f32x4_t;
#define MFMA32(a, b, c) __builtin_amdgcn_mfma_f32_32x32x16_bf16((a), (b), (c), 0, 0, 0)

#ifndef MULTI_LAUNCH
#define MULTI_LAUNCH 0
#endif

constexpr int DM = 1024;
constexpr int NB = 4;
constexpr int SEQ = 8192;
constexpr int CTX = 256;
constexpr int LTOK = CTX + SEQ;
constexpr int T = NB * LTOK;
constexpr int NCH = LTOK / 64;
constexpr int FFH = 2816;
constexpr int NTHR = 512;
constexpr int GDN_IN = 4128;
constexpr int HG_IN = 5120;
constexpr size_t UB = (size_t)T * 1024 * 2;
constexpr int LDS_BYTES = 147456 + 512;

constexpr size_t OFF_SMALL = 7 * UB;
constexpr size_t OFF_AB  = OFF_SMALL;
constexpr size_t OFF_GC  = OFF_AB + (size_t)T * 32 * 4;
constexpr size_t OFF_BT  = OFF_GC + (size_t)64 * LTOK * 4;
constexpr size_t OFF_XC  = OFF_BT + (size_t)64 * LTOK * 4;
constexpr size_t OFF_MOD = OFF_XC + (size_t)NB * CTX * DM * 4;
constexpr size_t OFF_WB  = OFF_MOD + (size_t)4 * 5 * 6144 * 4;
constexpr size_t WB_W1 = 0, WB_W3 = (size_t)FFH * 1024, WB_W2 = 2 * (size_t)FFH * 1024, WB_IN = 3 * (size_t)FFH * 1024;
constexpr size_t WB_OUT = WB_IN + (size_t)5120 * 1024, WB_GATE = WB_OUT + (size_t)1024 * 1024, WB_END = WB_GATE + (size_t)32 * 128 * 128;
constexpr size_t OFF_BAR = OFF_WB + WB_END * 2;
constexpr size_t BAR_BYTES = 3456 * 4;
constexpr size_t WS_NEED = OFF_BAR + BAR_BYTES;

struct Params {
  const float *x, *c, *ctx, *c_ctx, *ada_w, *ada_b, *norm_mix, *norm_ffn, *norm_final;
  const float *ffn_w1, *ffn_w3, *ffn_w2;
  const float *gdn_w_in, *gdn_conv, *gdn_a_log, *gdn_dt_bias, *gdn_norm, *gdn_w_out;
  const float *lru_w_in, *lru_conv_w, *lru_conv_b, *lru_w_r, *lru_b_r, *lru_w_i, *lru_b_i, *lru_lambda, *lru_w_out;
  const float *hg_w_in, *hg_lb_logits, *hg_norm, *hg_w_out;
  float* out;
  char* ws;
  int ph_lo, ph_hi;
};

typedef __attribute__((ext_vector_type(2))) float f2_t;
typedef __attribute__((ext_vector_type(2))) __bf16 bf2_t;
DI bfr f2bf(float x) { __bf16 r = (__bf16)x; return __builtin_bit_cast(bfr, r); }
DI float bf2f(bfr v) { return __uint_as_float(((unsigned)v) << 16); }
DI unsigned pack2(float a, float b) { f2_t v = {a, b}; bf2_t r = __builtin_convertvector(v, bf2_t); return __builtin_bit_cast(unsigned, r); }
DI uint2 pack4(float a, float b, float c, float d) { uint2 u; u.x = pack2(a, b); u.y = pack2(c, d); return u; }
DI float lo2f(unsigned u) { return __uint_as_float(u << 16); }
DI float hi2f(unsigned u) { return __uint_as_float(u & 0xffff0000u); }
DI float sigmoidf_(float x) { return __builtin_amdgcn_rcpf(1.f + __expf(-x)); }
DI float siluf_(float x) { return x * __builtin_amdgcn_rcpf(1.f + __expf(-x)); }
DI float softplusf_(float x) { return x > 20.f ? x : log1pf(expf(x)); }
DI float geluf_(float x) { float u = 0.7978845608028654f * (x + 0.044715f * x * x * x); float t = 1.f - 2.f * __builtin_amdgcn_rcpf(1.f + __expf(2.f * u)); return 0.5f * x * (1.f + t); }
DI int tid_() { int t = threadIdx.x; asm volatile("" : "+v"(t)); return t; }
DI int bid_() { int t = blockIdx.x; asm volatile("" : "+s"(t)); return t; }
#define LDS_BARRIER() { asm volatile("s_waitcnt lgkmcnt(0)" ::: "memory"); __builtin_amdgcn_s_barrier(); asm volatile("" ::: "memory"); }
DI int crow(int reg, int hh) { return (reg & 3) + 8 * (reg >> 2) + 4 * hh; }

DI void xrow_ptr(const Params& p, int r, bool colmaj, bool first, const float*& xin, float*& xout, int& modrow) {
  int b = r / LTOK, q = r - b * LTOK;
  if (q < CTX) {
    size_t o = ((size_t)b * CTX + q) * DM;
    xout = (float*)(p.ws + OFF_XC) + o;
    xin = first ? p.ctx + o : xout;
    modrow = 4;
  } else {
    int s = q - CTX;
    int orig = colmaj ? ((s & 127) * 64 + (s >> 7)) : s;
    size_t o = ((size_t)b * SEQ + orig) * DM;
    xout = p.out + o;
    xin = first ? p.x + o : xout;
    modrow = b;
  }
}

DI void phase_mod(const Params& p, char* lds) {
  float* sc = (float*)lds;
  float* red = sc + 5 * 1024;
  const int tid = tid_();
  for (int i = tid; i < 5 * 1024; i += NTHR) {
    int r = i >> 10, k = i & 1023;
    float v = (r < 4) ? p.c[r * 1024 + k] : p.c_ctx[k];
    sc[i] = siluf_(v);
  }
  __syncthreads();
  float* MOD = (float*)(p.ws + OFF_MOD);
  const int col = tid & 63, kq = tid >> 6;
  for (int item = bid_(); item < 4 * 96; item += gridDim.x) {
    int l = item / 96, n = (item % 96) * 64 + col;
    const float* w = p.ada_w + (size_t)l * 1024 * 6144 + n;
    float a0 = 0, a1 = 0, a2 = 0, a3 = 0, a4 = 0;
#pragma unroll 8
    for (int k = kq * 128; k < kq * 128 + 128; ++k) {
      float wv = w[(size_t)k * 6144];
      a0 += sc[k] * wv; a1 += sc[1024 + k] * wv; a2 += sc[2048 + k] * wv; a3 += sc[3072 + k] * wv; a4 += sc[4096 + k] * wv;
    }
    red[(kq * 5 + 0) * 64 + col] = a0; red[(kq * 5 + 1) * 64 + col] = a1; red[(kq * 5 + 2) * 64 + col] = a2;
    red[(kq * 5 + 3) * 64 + col] = a3; red[(kq * 5 + 4) * 64 + col] = a4;
    __syncthreads();
    if (tid < 320) {
      int r = tid >> 6, c = tid & 63;
      float s = 0;
      for (int q = 0; q < 8; ++q) s += red[(q * 5 + r) * 64 + c];
      int nn = (item % 96) * 64 + c;
      MOD[((size_t)l * 5 + r) * 6144 + nn] = s + p.ada_b[l * 6144 + nn];
    }
    __syncthreads();
  }
}

DI void phase_norm(const Params& p, int layer, const float* nw, int shi, int sci, bool colmaj, bool first) {
  const int lane = tid_() & 63, w = tid_() >> 6;
  bfr* H = (bfr*)p.ws;
  const float* MOD = (const float*)(p.ws + OFF_MOD) + (size_t)layer * 5 * 6144;
  const int stride = gridDim.x * 8;
  float4 wv[4];
#pragma unroll
  for (int i = 0; i < 4; ++i) wv[i] = *(const float4*)(nw + lane * 4 + 256 * i);
  for (int r0 = bid_() * 8 + w; r0 < T; r0 += 2 * stride) {
    float4 v[2][4]; int mr[2]; float ss[2];
#pragma unroll
    for (int k = 0; k < 2; ++k) {
      const int r = r0 + k * stride < T ? r0 + k * stride : r0;
      const float* xin; float* xout;
      xrow_ptr(p, r, colmaj, first, xin, xout, mr[k]);
#pragma unroll
      for (int i = 0; i < 4; ++i) v[k][i] = *(const float4*)(xin + lane * 4 + 256 * i);
    }
#pragma unroll
    for (int k = 0; k < 2; ++k) {
      float a = 0;
#pragma unroll
      for (int i = 0; i < 4; ++i) a += v[k][i].x * v[k][i].x + v[k][i].y * v[k][i].y + v[k][i].z * v[k][i].z + v[k][i].w * v[k][i].w;
#pragma unroll
      for (int o = 32; o > 0; o >>= 1) a += __shfl_xor(a, o);
      ss[k] = rsqrtf(a * (1.f / 1024.f) + 1e-6f);
    }
#pragma unroll
    for (int k = 0; k < 2; ++k) {
      const int r = r0 + k * stride;
      if (r < T) {
        const float* sh = MOD + mr[k] * 6144 + shi * 1024;
        const float* scl = MOD + mr[k] * 6144 + sci * 1024;
#pragma unroll
        for (int i = 0; i < 4; ++i) {
          const int kk = lane * 4 + 256 * i;
          const float4 s4 = *(const float4*)(sh + kk), c4 = *(const float4*)(scl + kk);
          const float rstd = ss[k];
          *(uint2*)(H + (size_t)r * 1024 + kk) = pack4(v[k][i].x * rstd * wv[i].x * (1.f + c4.x) + s4.x, v[k][i].y * rstd * wv[i].y * (1.f + c4.y) + s4.y,
                                                     v[k][i].z * rstd * wv[i].z * (1.f + c4.z) + s4.z, v[k][i].w * rstd * wv[i].w * (1.f + c4.w) + s4.w);
        }
      }
    }
  }
}

DI void wprep_mat(const float* src, int K, int N, bfr* dst, int& off, float* tl, int vb, int VG) {
  const int tid = tid_();
  const int tk = K >> 6, tn = (N + 63) >> 6, ntile = tk * tn;
  const int G = VG;
  int start = (vb + G - (off % G)) % G;
  off += ntile;
  const int kr = tid >> 4, n4 = (tid & 15) * 4;
  float4 v0 = make_float4(0, 0, 0, 0), v1 = v0;
#define WP_LOAD(t_)                                                                     \
  {                                                                                     \
    const int k0_ = ((t_) % tk) * 64, n0_ = ((t_) / tk) * 64;                           \
    v0 = make_float4(0, 0, 0, 0); v1 = v0;                                              \
    if (n0_ + n4 < N) { v0 = *(const float4*)(src + (size_t)(k0_ + kr) * N + n0_ + n4); v1 = *(const float4*)(src + (size_t)(k0_ + kr + 32) * N + n0_ + n4); } \
  }
  if (start < ntile) WP_LOAD(start);
  for (int t = start; t < ntile; t += G) {
    const int kt = t % tk, nt = t / tk;
    const int k0 = kt * 64, n0 = nt * 64;
    {
      float* d = tl + kr * 65 + n4;
      d[0] = v0.x; d[1] = v0.y; d[2] = v0.z; d[3] = v0.w;
      d += 32 * 65;
      d[0] = v1.x; d[1] = v1.y; d[2] = v1.z; d[3] = v1.w;
    }
    if (t + G < ntile) WP_LOAD(t + G);
    LDS_BARRIER();
    {
      int n = tid >> 3, k8 = (tid & 7) * 8;
      if (n0 + n < N) {
        float f[8];
#pragma unroll
        for (int e = 0; e < 8; ++e) f[e] = tl[(k8 + e) * 65 + n];
        *(uint4*)(dst + (size_t)(n0 + n) * K + k0 + k8) = make_uint4(pack2(f[0], f[1]), pack2(f[2], f[3]), pack2(f[4], f[5]), pack2(f[6], f[7]));
      }
    }
    LDS_BARRIER();
  }
#undef WP_LOAD
}

DI void phase_wprep(const Params& p, int layer, char* lds, int mask, int vb, int VG) {
  if (vb < 0) return;
  float* tl = (float*)lds;
  bfr* WB = (bfr*)(p.ws + OFF_WB);
  const int kind = layer % 3, jl = layer / 3;
  int off = 0;
  if (mask & 1) {
    wprep_mat(p.ffn_w1 + (size_t)layer * 1024 * FFH, 1024, FFH, WB + WB_W1, off, tl, vb, VG);
    wprep_mat(p.ffn_w3 + (size_t)layer * 1024 * FFH, 1024, FFH, WB + WB_W3, off, tl, vb, VG);
  }
  if (mask & 2) wprep_mat(p.ffn_w2 + (size_t)layer * FFH * 1024, FFH, 1024, WB + WB_W2, off, tl, vb, VG);
  if (mask & 4) {
    if (kind == 0) {
      wprep_mat(p.gdn_w_in + (size_t)jl * 1024 * GDN_IN, 1024, GDN_IN, WB + WB_IN, off, tl, vb, VG);
      wprep_mat(p.gdn_w_out + (size_t)jl * 1024 * 1024, 1024, 1024, WB + WB_OUT, off, tl, vb, VG);
    } else if (kind == 1) {
      wprep_mat(p.lru_w_in + (size_t)jl * 1024 * 2048, 1024, 2048, WB + WB_IN, off, tl, vb, VG);
      wprep_mat(p.lru_w_out + (size_t)jl * 1024 * 1024, 1024, 1024, WB + WB_OUT, off, tl, vb, VG);
#pragma unroll 1
      for (int m = 0; m < 32; ++m) {
        int d = m >> 4, which = (m >> 3) & 1, g = m & 7;
        const float* src = (which ? p.lru_w_i : p.lru_w_r) + ((size_t)(jl * 2 + d) * 8 + g) * 128 * 128;
        wprep_mat(src, 128, 128, WB + WB_GATE + (size_t)m * 128 * 128, off, tl, vb, VG);
      }
    } else {
      wprep_mat(p.hg_w_in + (size_t)jl * 1024 * HG_IN, 1024, HG_IN, WB + WB_IN, off, tl, vb, VG);
      wprep_mat(p.hg_w_out + (size_t)jl * 1024 * 1024, 1024, 1024, WB + WB_OUT, off, tl, vb, VG);
    }
  }
}

template <int BM, class Epi>
DI void gemm_phase(const bfr* A, int lda, int K, int NT, const Epi& epi, char* lds, int mt_off = 0, int MT = T / BM) {
  constexpr int MI = BM / 128;
  constexpr int AI = BM / 64;
  constexpr int LS = 72;
  constexpr int LA_ = BM * LS;
  constexpr int LB_ = 128 * LS;
  bfr* sA0 = (bfr*)lds; bfr* sB0 = sA0 + LA_; bfr* sA1 = sB0 + LB_; bfr* sB1 = sA1 + LA_;
  float* stg = (float*)lds;
  const int tid = tid_(), lane = tid & 63, w = tid >> 6, wm = w >> 1, wn = w & 1, l31 = lane & 31, hh = lane >> 5;
  const int KT = K / 64;
  const int crow_ = tid >> 3, kc = (tid & 7) * 8;
  const int G = gridDim.x, bid = bid_();
  const int ntiles = MT * NT;
  int ctile = (bid & 7) * (G >> 3) + (bid >> 3);
  if (ctile >= ntiles) return;
  int ltile = ctile;
  const bfr *lap, *lb0, *lb1;
  bool lvalid = true;
#define SETLOAD(t_)                                                                      \
  {                                                                                      \
    const int band_ = (t_) / (4 * NT), within_ = (t_) - band_ * 4 * NT;                  \
    const int nt_ = within_ >> 2, mt_ = band_ * 4 + (within_ & 3);                       \
    lap = A + (size_t)((mt_ + mt_off) * BM + crow_) * lda + epi.aoff(nt_) + kc;                     \
    lb0 = epi.brow(nt_, crow_); lb1 = epi.brow(nt_, crow_ + 64);                         \
  }
  uint4 r0a0, r0a1, r0a2, r0a3, r0b0, r0b1, r1a0, r1a1, r1a2, r1a3, r1b0, r1b1;
  r0a1 = r0a2 = r0a3 = r1a1 = r1a2 = r1a3 = make_uint4(0, 0, 0, 0);
#define GLOADR(R_, k_)                                                                  \
  {                                                                                      \
    R_##a0 = *(const uint4*)(lap + (k_) * 64);                                           \
    if (AI > 1) R_##a1 = *(const uint4*)(lap + (size_t)64 * lda + (k_) * 64);            \
    if (AI > 2) { R_##a2 = *(const uint4*)(lap + (size_t)128 * lda + (k_) * 64); R_##a3 = *(const uint4*)(lap + (size_t)192 * lda + (k_) * 64); } \
    R_##b0 = lb0 ? *(const uint4*)(lb0 + kc + (k_) * 64) : make_uint4(0, 0, 0, 0);       \
    R_##b1 = lb1 ? *(const uint4*)(lb1 + kc + (k_) * 64) : make_uint4(0, 0, 0, 0);       \
  }
#define SWRITER(sA_, sB_, R_)                                                            \
  {                                                                                      \
    *(uint4*)(sA_ + crow_ * LS + kc) = R_##a0;                                           \
    if (AI > 1) *(uint4*)(sA_ + (crow_ + 64) * LS + kc) = R_##a1;                        \
    if (AI > 2) { *(uint4*)(sA_ + (crow_ + 128) * LS + kc) = R_##a2; *(uint4*)(sA_ + (crow_ + 192) * LS + kc) = R_##a3; } \
    *(uint4*)(sB_ + crow_ * LS + kc) = R_##b0;                                           \
    *(uint4*)(sB_ + (crow_ + 64) * LS + kc) = R_##b1;                                    \
  }
#define COMPUTE(sA_, sB_)                                                                \
  {                                                                                      \
    _Pragma("unroll") for (int ks = 0; ks < 4; ++ks) {                                   \
      bf16x8 af[MI], bg[2];                                                              \
      _Pragma("unroll") for (int mi = 0; mi < MI; ++mi) af[mi] = *(const bf16x8*)(sA_ + (wm * (BM / 4) + mi * 32 + l31) * LS + ks * 16 + hh * 8); \
      _Pragma("unroll") for (int ni = 0; ni < 2; ++ni) bg[ni] = *(const bf16x8*)(sB_ + (wn * 64 + ni * 32 + l31) * LS + ks * 16 + hh * 8); \
      _Pragma("unroll") for (int mi = 0; mi < MI; ++mi)                                  \
        _Pragma("unroll") for (int ni = 0; ni < 2; ++ni) acc[mi][ni] = MFMA32(af[mi], bg[ni], acc[mi][ni]); \
    }                                                                                    \
  }
  SETLOAD(ltile);
  GLOADR(r0, 0);
  GLOADR(r1, 1);
  SWRITER(sA0, sB0, r0);
  LDS_BARRIER();
  while (true) {
    const int band = ctile / (4 * NT), within = ctile - band * 4 * NT;
    const int nt = within >> 2, mt = band * 4 + (within & 3);
    const int m0 = (mt + mt_off) * BM;
    f32x16 acc[MI][2];
#pragma unroll
    for (int mi = 0; mi < MI; ++mi)
#pragma unroll
      for (int ni = 0; ni < 2; ++ni)
#pragma unroll
        for (int e = 0; e < 16; ++e) acc[mi][ni][e] = 0.f;
    for (int kt = 0; kt < KT; kt += 2) {
      int lk = kt + 2;
      if (lk == KT) {
        lk = 0; ltile += G; lvalid = ltile < ntiles;
        if (lvalid) SETLOAD(ltile);
      }
      if (lvalid) GLOADR(r0, lk);
      __builtin_amdgcn_sched_barrier(0);
      COMPUTE(sA0, sB0);
      __builtin_amdgcn_sched_barrier(0);
      SWRITER(sA1, sB1, r1);
      LDS_BARRIER();
      if (lvalid) GLOADR(r1, lk + 1);
      __builtin_amdgcn_sched_barrier(0);
      COMPUTE(sA1, sB1);
      __builtin_amdgcn_sched_barrier(0);
      if (kt + 2 < KT) { SWRITER(sA0, sB0, r0); LDS_BARRIER(); }
    }
    LDS_BARRIER();
    if (Epi::STAGED) {
#pragma unroll
      for (int mi = 0; mi < MI; ++mi)
#pragma unroll
        for (int ni = 0; ni < 2; ++ni)
#pragma unroll
          for (int reg = 0; reg < 16; ++reg)
            stg[(wm * (BM / 4) + mi * 32 + crow(reg, hh)) * 132 + wn * 64 + ni * 32 + l31] = acc[mi][ni][reg];
      __syncthreads();
#pragma unroll 4
      for (int idx = tid; idx < BM * 32; idx += NTHR) {
        const int row = idx >> 5, c4 = (idx & 31) * 4;
        epi.store_row4(nt, m0 + row, c4, stg + row * 132);
      }
      __syncthreads();
    } else {
#pragma unroll
      for (int mi = 0; mi < MI; ++mi)
#pragma unroll
        for (int g = 0; g < 4; ++g) {
          int row0 = m0 + wm * (BM / 4) + mi * 32 + 8 * g + 4 * hh;
          float v0[4] = {acc[mi][0][4 * g], acc[mi][0][4 * g + 1], acc[mi][0][4 * g + 2], acc[mi][0][4 * g + 3]};
          float v1[4] = {acc[mi][1][4 * g], acc[mi][1][4 * g + 1], acc[mi][1][4 * g + 2], acc[mi][1][4 * g + 3]};
          epi.store4(nt, row0, wn, l31, v0, v1);
        }
    }
    ctile += G;
    if (ctile >= ntiles) break;
    SWRITER(sA0, sB0, r0);
    __syncthreads();
  }
#undef SETLOAD
#undef GLOADR
#undef SWRITER
#undef COMPUTE
}

template <class Epi>
DI void gemm_phase_big(const bfr* A, int lda, int K, int NT, const Epi& epi, char* lds) {
  constexpr int LS = 72;
  constexpr int LT_ = 256 * LS;
  bfr* sA0 = (bfr*)lds; bfr* sB0 = sA0 + LT_; bfr* sA1 = sB0 + LT_; bfr* sB1 = sA1 + LT_;
  float* stg = (float*)lds;
  const int tid = tid_(), lane = tid & 63, w = tid >> 6, wm = w >> 1, wn = w & 1, l31 = lane & 31, hh = lane >> 5;
  const int MT = T / 256, KT = K / 64;
  const int crow_ = tid >> 3, kc = (tid & 7) * 8;
  const int G = gridDim.x, bid = bid_();
  const int ntiles = MT * NT;
  int ctile = (bid & 7) * (G >> 3) + (bid >> 3);
  if (ctile >= ntiles) return;
  int ltile = ctile;
  const bfr *lap, *lbp;
  bool lv0 = true, lv1 = true, lv2 = true, lv3 = true;
  bool lvalid = true;
  const size_t bstr = epi.bstride();
#define SETLOAD(t_)                                                                      \
  {                                                                                      \
    const int band_ = (t_) / (4 * NT), within_ = (t_) - band_ * 4 * NT;                  \
    const int nt_ = within_ >> 2, mt_ = band_ * 4 + (within_ & 3);                       \
    lap = A + (size_t)(mt_ * 256 + crow_) * lda + kc;                                    \
    lbp = epi.bbase(nt_, crow_) + kc;                                                    \
    if (Epi::BCHECK) { lv0 = epi.bvalid(nt_, crow_, 0); lv1 = epi.bvalid(nt_, crow_, 1); lv2 = epi.bvalid(nt_, crow_, 2); lv3 = epi.bvalid(nt_, crow_, 3); } \
  }
  uint4 ra0, ra1, ra2, ra3, rb0, rb1, rb2, rb3;
#define GLOADR(k_)                                                                       \
  {                                                                                      \
    ra0 = *(const uint4*)(lap + (k_) * 64);                                              \
    ra1 = *(const uint4*)(lap + (size_t)64 * lda + (k_) * 64);                           \
    ra2 = *(const uint4*)(lap + (size_t)128 * lda + (k_) * 64);                          \
    ra3 = *(const uint4*)(lap + (size_t)192 * lda + (k_) * 64);                          \
    rb0 = (!Epi::BCHECK || lv0) ? *(const uint4*)(lbp + (k_) * 64) : make_uint4(0, 0, 0, 0);            \
    rb1 = (!Epi::BCHECK || lv1) ? *(const uint4*)(lbp + bstr + (k_) * 64) : make_uint4(0, 0, 0, 0);     \
    rb2 = (!Epi::BCHECK || lv2) ? *(const uint4*)(lbp + 2 * bstr + (k_) * 64) : make_uint4(0, 0, 0, 0); \
    rb3 = (!Epi::BCHECK || lv3) ? *(const uint4*)(lbp + 3 * bstr + (k_) * 64) : make_uint4(0, 0, 0, 0); \
  }
#define SWRITER(sA_, sB_)                                                                \
  {                                                                                      \
    *(uint4*)(sA_ + crow_ * LS + kc) = ra0; *(uint4*)(sA_ + (crow_ + 64) * LS + kc) = ra1; \
    *(uint4*)(sA_ + (crow_ + 128) * LS + kc) = ra2; *(uint4*)(sA_ + (crow_ + 192) * LS + kc) = ra3; \
    *(uint4*)(sB_ + crow_ * LS + kc) = rb0; *(uint4*)(sB_ + (crow_ + 64) * LS + kc) = rb1; \
    *(uint4*)(sB_ + (crow_ + 128) * LS + kc) = rb2; *(uint4*)(sB_ + (crow_ + 192) * LS + kc) = rb3; \
  }
#define COMPUTE(sA_, sB_)                                                                \
  {                                                                                      \
    _Pragma("unroll") for (int ks = 0; ks < 4; ++ks) {                                   \
      bf16x8 af[2], bg[4];                                                               \
      _Pragma("unroll") for (int mi = 0; mi < 2; ++mi) af[mi] = *(const bf16x8*)(sA_ + (wm * 64 + mi * 32 + l31) * LS + ks * 16 + hh * 8); \
      _Pragma("unroll") for (int ni = 0; ni < 4; ++ni) bg[ni] = *(const bf16x8*)(sB_ + (wn * 128 + ni * 32 + l31) * LS + ks * 16 + hh * 8); \
      _Pragma("unroll") for (int mi = 0; mi < 2; ++mi)                                   \
        _Pragma("unroll") for (int ni = 0; ni < 4; ++ni) acc[mi][ni] = MFMA32(af[mi], bg[ni], acc[mi][ni]); \
    }                                                                                    \
  }
  SETLOAD(ltile);
  GLOADR(0);
  SWRITER(sA0, sB0);
  __syncthreads();
  while (true) {
    const int band = ctile / (4 * NT), within = ctile - band * 4 * NT;
    const int nt = within >> 2, mt = band * 4 + (within & 3);
    const int m0 = mt * 256;
    f32x16 acc[2][4];
#pragma unroll
    for (int mi = 0; mi < 2; ++mi)
#pragma unroll
      for (int ni = 0; ni < 4; ++ni)
#pragma unroll
        for (int e = 0; e < 16; ++e) acc[mi][ni][e] = 0.f;
    for (int kt = 0; kt < KT; kt += 2) {
      GLOADR(kt + 1);
      __builtin_amdgcn_sched_barrier(0);
      COMPUTE(sA0, sB0);
      __builtin_amdgcn_sched_barrier(0);
      SWRITER(sA1, sB1);
      __syncthreads();
      int lk = kt + 2;
      if (lk == KT) {
        lk = 0; ltile += G; lvalid = ltile < ntiles;
        if (lvalid) SETLOAD(ltile);
      }
      if (lvalid) GLOADR(lk);
      __builtin_amdgcn_sched_barrier(0);
      COMPUTE(sA1, sB1);
      __builtin_amdgcn_sched_barrier(0);
      if (kt + 2 < KT) { SWRITER(sA0, sB0); }
      __syncthreads();
    }
    if (Epi::DUAL) {
#pragma unroll
      for (int mi = 0; mi < 2; ++mi)
#pragma unroll
        for (int q = 0; q < 2; ++q)
#pragma unroll
          for (int reg = 0; reg < 16; ++reg)
            stg[(wm * 64 + mi * 32 + crow(reg, hh)) * 132 + wn * 64 + q * 32 + l31] = epi.dual(acc[mi][2 * q][reg], acc[mi][2 * q + 1][reg]);
      __syncthreads();
#pragma unroll 4
      for (int idx = tid; idx < 256 * 32; idx += NTHR) {
        const int row = idx >> 5, c4 = (idx & 31) * 4;
        epi.store_dual4(nt, m0 + row, c4, *(const float4*)(stg + row * 132 + c4));
      }
      __syncthreads();
    } else if (Epi::STAGED) {
#pragma unroll
      for (int half = 0; half < 2; ++half) {
        if (wn == half) {
#pragma unroll
          for (int mi = 0; mi < 2; ++mi)
#pragma unroll
            for (int ni = 0; ni < 4; ++ni)
#pragma unroll
              for (int reg = 0; reg < 16; ++reg)
                stg[(wm * 64 + mi * 32 + crow(reg, hh)) * 132 + ni * 32 + l31] = acc[mi][ni][reg];
        }
        __syncthreads();
#pragma unroll 4
        for (int idx = tid; idx < 256 * 32; idx += NTHR) {
          const int row = idx >> 5, c4 = (idx & 31) * 4;
          epi.store_row4b(nt, half, m0 + row, c4, stg + row * 132);
        }
        __syncthreads();
      }
    } else {
#pragma unroll
      for (int mi = 0; mi < 2; ++mi)
#pragma unroll
        for (int ni = 0; ni < 4; ++ni)
#pragma unroll
          for (int g = 0; g < 4; ++g) {
            int row0 = m0 + wm * 64 + mi * 32 + 8 * g + 4 * hh;
            float v0[4] = {acc[mi][ni][4 * g], acc[mi][ni][4 * g + 1], acc[mi][ni][4 * g + 2], acc[mi][ni][4 * g + 3]};
            epi.store4b(nt * 256 + wn * 128 + ni * 32 + l31, row0, v0);
          }
    }
    ctile += G;
    if (ctile >= ntiles) break;
    SWRITER(sA0, sB0);
    __syncthreads();
  }
#undef SETLOAD
#undef GLOADR
#undef SWRITER
#undef COMPUTE
}

template <class Epi>
DI void gemm_phase_glds(const bfr* A, int NT, const Epi& epi, char* lds, int K = 1024, int MT = T / 256) {
  constexpr int STGB = 65536;
  float* stg = (float*)lds;
  const int tid = tid_(), lane = tid & 63, w = tid >> 6, wm = w >> 1, wn = w & 1, l31 = lane & 31, hh = lane >> 5;
  const int KT = K >> 6;
  const int G = gridDim.x, bid = bid_();
  const int ntiles = MT * NT;
  const int lrow = lane >> 3;
  const int lc = (lane & 7) ^ ((4 * (w & 1) + (lrow >> 1)) & 7);
  const int swz = (l31 >> 1) & 7;
  const int wofs = __builtin_amdgcn_readfirstlane(w) * 1024;
  const size_t bstr = epi.bstride();
#define WAITV(n_) asm volatile("s_waitcnt vmcnt(" #n_ ")" ::: "memory")
#define RAWBAR() { asm volatile("s_waitcnt lgkmcnt(0)" ::: "memory"); __builtin_amdgcn_s_barrier(); asm volatile("" ::: "memory"); }
#define GLDS(g_, l_) __builtin_amdgcn_global_load_lds((const unsigned*)(g_), (__attribute__((address_space(3))) unsigned*)(l_), 16, 0, 0)
#define ISSUE(s_, slot_)                                                                 \
  {                                                                                      \
    char* sb_ = lds + (slot_) * STGB + wofs;                                             \
    GLDS(ga + (s_) * 64, sb_); GLDS(ga + (size_t)64 * K + (s_) * 64, sb_ + 8192);        \
    GLDS(ga + (size_t)128 * K + (s_) * 64, sb_ + 16384); GLDS(ga + (size_t)192 * K + (s_) * 64, sb_ + 24576); \
    GLDS(gb + (s_) * 64, sb_ + 32768); GLDS(gb + bstr + (s_) * 64, sb_ + 40960);         \
    GLDS(gb + 2 * bstr + (s_) * 64, sb_ + 49152); GLDS(gb + 3 * bstr + (s_) * 64, sb_ + 57344); \
  }
#define COMPUTE(slot_)                                                                   \
  {                                                                                      \
    const char* sa_ = lds + (slot_) * STGB + (wm * 64 + l31) * 128;                      \
    const char* sb_ = lds + (slot_) * STGB + 32768 + (wn * 128 + l31) * 128;             \
    _Pragma("unroll") for (int ks = 0; ks < 4; ++ks) {                                   \
      const int ok_ = ((ks * 2 + hh) ^ swz) * 16;                                        \
      bf16x8 af[2], bg[4];                                                               \
      _Pragma("unroll") for (int mi = 0; mi < 2; ++mi) af[mi] = *(const bf16x8*)(sa_ + mi * 4096 + ok_); \
      _Pragma("unroll") for (int ni = 0; ni < 4; ++ni) bg[ni] = *(const bf16x8*)(sb_ + ni * 4096 + ok_); \
      _Pragma("unroll") for (int mi = 0; mi < 2; ++mi)                                   \
        _Pragma("unroll") for (int ni = 0; ni < 4; ++ni) acc[mi][ni] = MFMA32(af[mi], bg[ni], acc[mi][ni]); \
    }                                                                                    \
  }
  for (int ctile = (bid & 7) * (G >> 3) + (bid >> 3); ctile < ntiles; ctile += G) {
    const int band = ctile / (4 * NT), within = ctile - band * 4 * NT;
    const int nt = within >> 2, mt = band * 4 + (within & 3);
    const int m0 = mt * 256;
    const bfr* ga = A + (size_t)(m0 + 8 * w + lrow) * K + lc * 8;
    const bfr* gb = epi.bbase(nt, 8 * w + lrow) + lc * 8;
    f32x16 acc[2][4];
#pragma unroll
    for (int mi = 0; mi < 2; ++mi)
#pragma unroll
      for (int ni = 0; ni < 4; ++ni)
#pragma unroll
        for (int e = 0; e < 16; ++e) acc[mi][ni][e] = 0.f;
    ISSUE(0, 0);
    WAITV(0); RAWBAR();
    for (int s2 = 0; s2 < KT; s2 += 2) {
      ISSUE(s2 + 1, 1); COMPUTE(0); WAITV(0); RAWBAR();
      if (s2 + 2 < KT) ISSUE(s2 + 2, 0);
      COMPUTE(1); WAITV(0); RAWBAR();
    }
    if (Epi::DUAL) {
#pragma unroll
      for (int mi = 0; mi < 2; ++mi)
#pragma unroll
        for (int q = 0; q < 2; ++q)
#pragma unroll
          for (int reg = 0; reg < 16; ++reg)
            stg[(wm * 64 + mi * 32 + crow(reg, hh)) * 132 + wn * 64 + q * 32 + l31] = epi.dual(acc[mi][2 * q][reg], acc[mi][2 * q + 1][reg]);
      __syncthreads();
#pragma unroll 4
      for (int idx = tid; idx < 256 * 32; idx += NTHR) {
        const int row = idx >> 5, c4 = (idx & 31) * 4;
        epi.store_dual4(nt, m0 + row, c4, *(const float4*)(stg + row * 132 + c4));
      }
      __syncthreads();
    } else if (Epi::STAGE16 && epi.use16(nt)) {
      bfr* st16 = (bfr*)lds;
#pragma unroll
      for (int mi = 0; mi < 2; ++mi)
#pragma unroll
        for (int ni = 0; ni < 4; ++ni)
#pragma unroll
          for (int reg = 0; reg < 16; ++reg)
            st16[(wm * 64 + mi * 32 + crow(reg, hh)) * 264 + wn * 128 + ni * 32 + l31] = f2bf(acc[mi][ni][reg]);
      __syncthreads();
#pragma unroll 4
      for (int idx = tid; idx < 256 * 32; idx += NTHR) {
        const int row = idx >> 5, c8 = (idx & 31) * 8;
        epi.store_row8(nt, m0 + row, c8, *(const uint4*)(st16 + row * 264 + c8));
      }
      __syncthreads();
    } else if (Epi::STAGED) {
#pragma unroll
      for (int half = 0; half < 2; ++half) {
        if (wn == half) {
#pragma unroll
          for (int mi = 0; mi < 2; ++mi)
#pragma unroll
            for (int ni = 0; ni < 4; ++ni)
#pragma unroll
              for (int reg = 0; reg < 16; ++reg)
                stg[(wm * 64 + mi * 32 + crow(reg, hh)) * 132 + ni * 32 + l31] = acc[mi][ni][reg];
        }
        __syncthreads();
#pragma unroll 4
        for (int idx = tid; idx < 256 * 32; idx += NTHR) {
          const int row = idx >> 5, c4 = (idx & 31) * 4;
          epi.store_row4b(nt, half, m0 + row, c4, stg + row * 132);
        }
        __syncthreads();
      }
    } else {
#pragma unroll
      for (int mi = 0; mi < 2; ++mi)
#pragma unroll
        for (int ni = 0; ni < 4; ++ni)
#pragma unroll
          for (int g = 0; g < 4; ++g) {
            int row0 = m0 + wm * 64 + mi * 32 + 8 * g + 4 * hh;
            float v0[4] = {acc[mi][ni][4 * g], acc[mi][ni][4 * g + 1], acc[mi][ni][4 * g + 2], acc[mi][ni][4 * g + 3]};
            epi.store4b(nt * 256 + wn * 128 + ni * 32 + l31, row0, v0);
          }
      __syncthreads();
    }
  }
#undef WAITV
#undef RAWBAR
#undef GLDS
#undef ISSUE
#undef COMPUTE
}

template <class Epi>
DI void gemm_phase_glds16(const bfr* A, int NT, const Epi& epi, char* lds, int K = 1024, int MT = T / 256, bool skipctx = false) {
  constexpr int STGB = 65536;
  float* stg = (float*)lds;
  const int tid = tid_(), lane = tid & 63, w = tid >> 6, wm = w >> 1, wn = w & 1, l15 = lane & 15, q4 = lane >> 4;
  const int KT = K >> 6;
  const int G = gridDim.x, bid = bid_();
  const int ntiles = MT * NT;
  const int lrow = lane >> 3;
  const int lc = (lane & 7) ^ ((4 * (w & 1) + (lrow >> 1)) & 7);
  const int swz = (l15 >> 1) & 7;
  const int wofs = __builtin_amdgcn_readfirstlane(w) * 1024;
  const size_t bstr = epi.bstride();
#define WAITV(n_) asm volatile("s_waitcnt vmcnt(" #n_ ")" ::: "memory")
#define RAWBAR() { asm volatile("s_waitcnt lgkmcnt(0)" ::: "memory"); __builtin_amdgcn_s_barrier(); asm volatile("" ::: "memory"); }
#define GLDS(g_, l_) __builtin_amdgcn_global_load_lds((const unsigned*)(g_), (__attribute__((address_space(3))) unsigned*)(l_), 16, 0, 0)
#define ISSUE(s_, slot_)                                                                 \
  {                                                                                      \
    char* sb_ = lds + (slot_) * STGB + wofs;                                             \
    GLDS(ga + (s_) * 64, sb_); GLDS(ga + (size_t)64 * K + (s_) * 64, sb_ + 8192);        \
    GLDS(ga + (size_t)128 * K + (s_) * 64, sb_ + 16384); GLDS(ga + (size_t)192 * K + (s_) * 64, sb_ + 24576); \
    GLDS(gb + (s_) * 64, sb_ + 32768); GLDS(gb + bstr + (s_) * 64, sb_ + 40960);         \
    GLDS(gb + 2 * bstr + (s_) * 64, sb_ + 49152); GLDS(gb + 3 * bstr + (s_) * 64, sb_ + 57344); \
  }
#define COMPUTE(slot_)                                                                   \
  {                                                                                      \
    const char* sa_ = lds + (slot_) * STGB + (wm * 64 + l15) * 128;                      \
    const char* sb_ = lds + (slot_) * STGB + 32768 + (wn * 128 + l15) * 128;             \
    _Pragma("unroll") for (int ks = 0; ks < 2; ++ks) {                                   \
      const int ok_ = ((ks * 4 + q4) ^ swz) * 16;                                        \
      bf16x8 af[4];                                                                      \
      _Pragma("unroll") for (int mi = 0; mi < 4; ++mi) af[mi] = *(const bf16x8*)(sa_ + mi * 2048 + ok_); \
      _Pragma("unroll") for (int nh = 0; nh < 2; ++nh) {                                 \
        bf16x8 bg[4];                                                                    \
        _Pragma("unroll") for (int ni = 0; ni < 4; ++ni) bg[ni] = *(const bf16x8*)(sb_ + (nh * 4 + ni) * 2048 + ok_); \
        _Pragma("unroll") for (int mi = 0; mi < 4; ++mi)                                 \
          _Pragma("unroll") for (int ni = 0; ni < 4; ++ni) acc[mi][nh * 4 + ni] = __builtin_amdgcn_mfma_f32_16x16x32_bf16(af[mi], bg[ni], acc[mi][nh * 4 + ni], 0, 0, 0); \
        __builtin_amdgcn_sched_barrier(0);                                               \
      }                                                                                  \
    }                                                                                    \
  }
  for (int ctile = (bid & 7) * (G >> 3) + (bid >> 3); ctile < ntiles; ctile += G) {
    const int band = ctile / (4 * NT), within = ctile - band * 4 * NT;
    const int nt = within >> 2, mte = band * 4 + (within & 3);
    const int mt = skipctx ? mte + (mte >> 5) + 1 : mte;
    const int m0 = mt * 256;
    const bfr* ga = A + (size_t)(m0 + 8 * w + lrow) * K + lc * 8;
    const bfr* gb = epi.bbase16(nt, 8 * w + lrow) + lc * 8;
    f32x4_t acc[4][8];
#pragma unroll
    for (int mi = 0; mi < 4; ++mi)
#pragma unroll
      for (int ni = 0; ni < 8; ++ni)
#pragma unroll
        for (int e = 0; e < 4; ++e) acc[mi][ni][e] = 0.f;
    ISSUE(0, 0);
    WAITV(0); RAWBAR();
    for (int s2 = 0; s2 < KT; s2 += 2) {
      ISSUE(s2 + 1, 1); COMPUTE(0); WAITV(0); RAWBAR();
      if (s2 + 2 < KT) ISSUE(s2 + 2, 0);
      COMPUTE(1); WAITV(0); RAWBAR();
    }
    if (Epi::DUAL) {
#pragma unroll
      for (int mi = 0; mi < 4; ++mi)
#pragma unroll
        for (int q = 0; q < 4; ++q)
#pragma unroll
          for (int e = 0; e < 4; ++e)
            stg[(wm * 64 + mi * 16 + 4 * q4 + e) * 132 + wn * 64 + q * 16 + l15] = epi.dual(acc[mi][2 * q][e], acc[mi][2 * q + 1][e]);
      __syncthreads();
#pragma unroll 4
      for (int idx = tid; idx < 256 * 32; idx += NTHR) {
        const int row = idx >> 5, c4 = (idx & 31) * 4;
        epi.store_dual4(nt, m0 + row, c4, *(const float4*)(stg + row * 132 + c4));
      }
      __syncthreads();
    } else if (Epi::STAGE16 && epi.use16(nt)) {
      bfr* st16 = (bfr*)lds;
#pragma unroll
      for (int mi = 0; mi < 4; ++mi)
#pragma unroll
        for (int ni = 0; ni < 8; ++ni)
#pragma unroll
          for (int e = 0; e < 4; ++e)
            st16[(wm * 64 + mi * 16 + 4 * q4 + e) * 264 + wn * 128 + ni * 16 + l15] = f2bf(acc[mi][ni][e]);
      __syncthreads();
#pragma unroll 4
      for (int idx = tid; idx < 256 * 32; idx += NTHR) {
        const int row = idx >> 5, c8 = (idx & 31) * 8;
        epi.store_row8(nt, m0 + row, c8, *(const uint4*)(st16 + row * 264 + c8));
      }
      __syncthreads();
    } else if (Epi::STAGED) {
#pragma unroll
      for (int half = 0; half < 2; ++half) {
        if (wn == half) {
#pragma unroll
          for (int mi = 0; mi < 4; ++mi)
#pragma unroll
            for (int ni = 0; ni < 8; ++ni)
#pragma unroll
              for (int e = 0; e < 4; ++e)
                stg[(wm * 64 + mi * 16 + 4 * q4 + e) * 132 + ni * 16 + l15] = acc[mi][ni][e];
        }
        __syncthreads();
#pragma unroll 4
        for (int idx = tid; idx < 256 * 32; idx += NTHR) {
          const int row = idx >> 5, c4 = (idx & 31) * 4;
          epi.store_row4b(nt, half, m0 + row, c4, stg + row * 132);
        }
        __syncthreads();
      }
    } else {
#pragma unroll
      for (int mi = 0; mi < 4; ++mi)
#pragma unroll
        for (int ni = 0; ni < 8; ++ni) {
          int row0 = m0 + wm * 64 + mi * 16 + 4 * q4;
          float v0[4] = {acc[mi][ni][0], acc[mi][ni][1], acc[mi][ni][2], acc[mi][ni][3]};
          epi.store4b(nt * 256 + wn * 128 + ni * 16 + l15, row0, v0);
        }
      __syncthreads();
    }
  }
#undef WAITV
#undef RAWBAR
#undef GLDS
#undef ISSUE
#undef COMPUTE
}


struct EpiGdnIn {
  static constexpr bool STAGE16 = true; static constexpr bool DUAL = false; static constexpr bool BCHECK = true; static constexpr bool STAGED = true;
  const bfr* W; bfr* PR; bfr* Z; float* AB;
  DI float dual(float a, float) const { return a; }
  DI void store_dual4(int, int, int, float4) const {}
  DI const bfr* browv(int nt, int v) const { int col = nt * 256 + v; col = col < GDN_IN ? col : GDN_IN - 1; return W + (size_t)col * 1024; }
  DI bool use16(int nt) const { return nt < 16; }
  DI void store_row8(int nt, int row, int c8, uint4 v) const { const int col = nt * 256 + c8; if (col < 3072) *(uint4*)(PR + (size_t)row * 3072 + col) = v; else *(uint4*)(Z + (size_t)row * 1024 + col - 3072) = v; }
  DI const bfr* bbase16(int nt, int r) const { return bbase(nt, r); }
  DI int aoff(int) const { return 0; }
  DI const bfr* brow(int nt, int v) const { int col = nt * 128 + v; return col < GDN_IN ? W + (size_t)col * 1024 : nullptr; }
  DI void store4b(int, int, const float*) const {}
  DI void store4(int, int, int, int, const float*, const float*) const {}
  DI size_t bstride() const { return (size_t)64 * 1024; }
  DI const bfr* bbase(int nt, int r) const { return W + (size_t)(nt * 256 + r) * 1024; }
  DI bool bvalid(int nt, int r, int i) const { return nt * 256 + r + 64 * i < GDN_IN; }
  DI void store_row4b(int nt, int half, int row, int c4, const float* rp) const { store_row4(nt * 2 + half, row, c4, rp); }
  DI void store_row4(int nt, int row, int c4, const float* rp) const {
    const int col = nt * 128 + c4;
    const float4 v = *(const float4*)(rp + c4);
    if (col < 3072) *(uint2*)(PR + (size_t)row * 3072 + col) = pack4(v.x, v.y, v.z, v.w);
    else if (col < 4096) *(uint2*)(Z + (size_t)row * 1024 + col - 3072) = pack4(v.x, v.y, v.z, v.w);
    else if (col < GDN_IN) *(float4*)(AB + (size_t)row * 32 + col - 4096) = v;
  }
};
struct EpiPlain {
  static constexpr bool STAGE16 = true; static constexpr bool DUAL = false; static constexpr bool BCHECK = false; static constexpr bool STAGED = true;
  const bfr* W; bfr* O; int ldo; int K;
  DI float dual(float a, float) const { return a; }
  DI void store_dual4(int, int, int, float4) const {}
  DI const bfr* browv(int nt, int v) const { return W + (size_t)(nt * 256 + v) * K; }
  DI bool use16(int) const { return true; }
  DI void store_row8(int nt, int row, int c8, uint4 v) const { *(uint4*)(O + (size_t)row * ldo + nt * 256 + c8) = v; }
  DI const bfr* bbase16(int nt, int r) const { return bbase(nt, r); }
  DI int aoff(int) const { return 0; }
  DI const bfr* brow(int nt, int v) const { return W + (size_t)(nt * 128 + v) * K; }
  DI void store4b(int, int, const float*) const {}
  DI void store4(int, int, int, int, const float*, const float*) const {}
  DI size_t bstride() const { return (size_t)64 * K; }
  DI const bfr* bbase(int nt, int r) const { return W + (size_t)(nt * 256 + r) * K; }
  DI bool bvalid(int, int, int) const { return true; }
  DI void store_row4b(int nt, int half, int row, int c4, const float* rp) const { store_row4(nt * 2 + half, row, c4, rp); }
  DI void store_row4(int nt, int row, int c4, const float* rp) const {
    const float4 v = *(const float4*)(rp + c4);
    *(uint2*)(O + (size_t)row * ldo + nt * 128 + c4) = pack4(v.x, v.y, v.z, v.w);
  }
};
struct EpiHgIn {
  static constexpr bool STAGE16 = true; static constexpr bool DUAL = false; static constexpr bool BCHECK = false; static constexpr bool STAGED = false;
  const bfr* W; char* ws;
  DI float dual(float a, float) const { return a; }
  DI void store_dual4(int, int, int, float4) const {}
  DI const bfr* browv(int nt, int v) const { return W + (size_t)(nt * 256 + v) * 1024; }
  DI bool use16(int nt) const { const int reg = nt >> 2; return reg == 0 || reg == 4; }
  DI void store_row8(int nt, int row, int c8, uint4 v) const { const int col = nt * 256 + c8; bfr* O = (bfr*)(ws + ((col >> 10) == 0 ? UB : 5 * UB)); *(uint4*)(O + (size_t)row * 1024 + (col & 1023)) = v; }
  DI const bfr* bbase16(int nt, int r) const { return bbase(nt, r); }
  DI int aoff(int) const { return 0; }
  DI const bfr* brow(int nt, int v) const { return W + (size_t)(nt * 128 + v) * 1024; }
  DI void store_row4(int, int, int, const float*) const {}
  DI void store_row4b(int, int, int, int, const float*) const {}
  DI size_t bstride() const { return (size_t)64 * 1024; }
  DI const bfr* bbase(int nt, int r) const { return W + (size_t)(nt * 256 + r) * 1024; }
  DI bool bvalid(int, int, int) const { return true; }
  DI void store4b(int col, int row0, const float* a) const {
    int reg = col >> 10, cc = col & 1023;
    if (reg == 0 || reg == 4) {
      bfr* O = (bfr*)(ws + (reg == 0 ? UB : 5 * UB));
#pragma unroll
      for (int e = 0; e < 4; ++e) O[(size_t)(row0 + e) * 1024 + cc] = f2bf(a[e]);
    } else {
      bfr* O = (bfr*)(ws + (size_t)(reg + 1) * UB);
      size_t o = ((size_t)(row0 >> 6) * 8 + (cc >> 7)) * 8192 + (cc & 127) * 64 + (row0 & 63);
      uint2 u; u.x = pack2(a[0], a[1]); u.y = pack2(a[2], a[3]);
      *(uint2*)(O + o) = u;
    }
  }
  DI void store4(int nt, int row0, int wn, int l31, const float* a0, const float* a1) const {
#pragma unroll
    for (int ni = 0; ni < 2; ++ni) {
      const float* a = ni ? a1 : a0;
      int col = nt * 128 + wn * 64 + ni * 32 + l31;
      int reg = col >> 10, cc = col & 1023;
      if (reg == 0 || reg == 4) {
        bfr* O = (bfr*)(ws + (reg == 0 ? UB : 5 * UB));
#pragma unroll
        for (int e = 0; e < 4; ++e) O[(size_t)(row0 + e) * 1024 + cc] = f2bf(a[e]);
      } else {
        bfr* O = (bfr*)(ws + (size_t)(reg + 1) * UB);
        size_t o = ((size_t)(row0 >> 6) * 8 + (cc >> 7)) * 8192 + (cc & 127) * 64 + (row0 & 63);
        uint2 u; u.x = pack2(a[0], a[1]); u.y = pack2(a[2], a[3]);
        *(uint2*)(O + o) = u;
      }
    }
  }
};
struct EpiResid {
  static constexpr bool STAGE16 = false; static constexpr bool DUAL = false; static constexpr bool BCHECK = false; static constexpr bool STAGED = true;
  const bfr* W; const Params* p; const float* gate; bool colmaj; bool first; int K;
  DI float dual(float a, float) const { return a; }
  DI void store_dual4(int, int, int, float4) const {}
  DI const bfr* browv(int nt, int v) const { return W + (size_t)(nt * 256 + v) * K; }
  DI void store_row4b(int nt, int half, int row, int c4, const float* rp) const { store_row4(nt * 2 + half, row, c4, rp); }
  DI void store4b(int, int, const float*) const {}
  DI size_t bstride() const { return (size_t)64 * K; }
  DI const bfr* bbase(int nt, int r) const { return W + (size_t)(nt * 256 + r) * K; }
  DI bool use16(int) const { return false; }
  DI void store_row8(int, int, int, uint4) const {}
  DI const bfr* bbase16(int nt, int r) const { return bbase(nt, r); }
  DI int aoff(int) const { return 0; }
  DI const bfr* brow(int nt, int v) const { return W + (size_t)(nt * 128 + v) * K; }
  DI void store4(int, int, int, int, const float*, const float*) const {}
  DI void store_row4(int nt, int row, int c4, const float* rp) const {
    const float* xin; float* xout; int mr;
    xrow_ptr(*p, row, colmaj, first, xin, xout, mr);
    const int col = nt * 128 + c4;
    const float4 v = *(const float4*)(rp + c4);
    const float4 x = *(const float4*)(xin + col);
    const float4 g = *(const float4*)(gate + mr * 6144 + col);
    float4 o; o.x = x.x + g.x * v.x; o.y = x.y + g.y * v.y; o.z = x.z + g.z * v.z; o.w = x.w + g.w * v.w;
    *(float4*)(xout + col) = o;
  }
};
struct EpiFfnUp {
  static constexpr bool STAGE16 = false; static constexpr bool DUAL = true; static constexpr bool BCHECK = false; static constexpr bool STAGED = true;
  const bfr* W1T; bfr* HID;
  DI float dual(float a, float b) const { return siluf_(a) * b; }
  DI void store_dual4(int nt, int row, int c4, float4 v) const { *(uint2*)(HID + (size_t)row * FFH + nt * 128 + c4) = pack4(v.x, v.y, v.z, v.w); }
  DI const bfr* browv(int nt, int v) const { return W1T + (((v >> 5) & 1) ? WB_W3 - WB_W1 : (size_t)0) + (size_t)(nt * 128 + (v >> 7) * 64 + ((v >> 6) & 1) * 32 + (v & 31)) * 1024; }
  DI bool use16(int) const { return false; }
  DI void store_row8(int, int, int, uint4) const {}
  DI const bfr* bbase16(int nt, int r) const { return W1T + (((r >> 4) & 1) ? WB_W3 - WB_W1 : (size_t)0) + (size_t)(nt * 128 + (r >> 5) * 16 + (r & 15)) * 1024; }
  DI int aoff(int) const { return 0; }
  DI const bfr* brow(int nt, int v) const {
    int wn_ = v >> 6, ni_ = (v >> 5) & 1, c = v & 31;
    return W1T + (ni_ ? WB_W3 - WB_W1 : (size_t)0) + (size_t)(nt * 64 + wn_ * 32 + c) * 1024;
  }
  DI void store4b(int, int, const float*) const {}
  DI void store4(int, int, int, int, const float*, const float*) const {}
  DI size_t bstride() const { return (size_t)32 * 1024; }
  DI const bfr* bbase(int nt, int r) const { return W1T + (((r >> 5) & 1) ? WB_W3 - WB_W1 : (size_t)0) + (size_t)(nt * 128 + (r & 31)) * 1024; }
  DI bool bvalid(int, int, int) const { return true; }
  DI void store_row4b(int nt, int half, int row, int c4, const float* rp) const { store_row4(nt * 2 + half, row, c4, rp); }
  DI void store_row4(int nt, int row, int c4, const float* rp) const {
    if (c4 & 32) return;
    const float4 a = *(const float4*)(rp + c4), b = *(const float4*)(rp + c4 + 32);
    const int col = nt * 64 + (c4 >> 6) * 32 + (c4 & 31);
    *(uint2*)(HID + (size_t)row * FFH + col) = pack4(siluf_(a.x) * b.x, siluf_(a.y) * b.y, siluf_(a.z) * b.z, siluf_(a.w) * b.w);
  }
};
struct EpiLruGate {
  static constexpr bool STAGE16 = false; static constexpr bool DUAL = false; static constexpr bool BCHECK = false; static constexpr bool STAGED = true;
  const bfr* WG; const float *br, *bi, *lam; const bfr* XR; bfr* LA; bfr* BV;
  DI float dual(float a, float) const { return a; }
  DI void store_dual4(int, int, int, float4) const {}
  DI bool use16(int) const { return false; }
  DI void store_row8(int, int, int, uint4) const {}
  DI int aoff(int nt) const { return ((nt >> 1) & 7) * 128; }
  DI const bfr* brow(int nt, int v) const {
    int wn_ = v >> 6, ni_ = (v >> 5) & 1, c = v & 31;
    int d = nt >> 4, g = (nt >> 1) & 7, half = nt & 1;
    return WG + ((size_t)(((d * 2 + ni_) * 8 + g) * 128) + half * 64 + wn_ * 32 + c) * 128;
  }
  DI void store4(int, int, int, int, const float*, const float*) const {}
  DI void store_row4(int nt, int row, int c4, const float* rp) const {
    if (c4 & 32) return;
    const int d = nt >> 4, g = (nt >> 1) & 7, half = nt & 1;
    const int ch = g * 128 + half * 64 + (c4 >> 6) * 32 + (c4 & 31);
    const float4 a = *(const float4*)(rp + c4), b = *(const float4*)(rp + c4 + 32);
    const float4 vbr = *(const float4*)(br + d * 1024 + ch), vbi = *(const float4*)(bi + d * 1024 + ch), vlm = *(const float4*)(lam + d * 1024 + ch);
    const uint2 xu = *(const uint2*)(XR + (size_t)row * 1024 + ch);
    const float av[4] = {a.x, a.y, a.z, a.w}, bv[4] = {b.x, b.y, b.z, b.w};
    const float rb[4] = {vbr.x, vbr.y, vbr.z, vbr.w}, ib[4] = {vbi.x, vbi.y, vbi.z, vbi.w}, lm[4] = {vlm.x, vlm.y, vlm.z, vlm.w};
    const float xr[4] = {lo2f(xu.x), hi2f(xu.x), lo2f(xu.y), hi2f(xu.y)};
    float la[4], bb[4];
#pragma unroll
    for (int e = 0; e < 4; ++e) {
      float r = sigmoidf_(av[e] + rb[e]);
      float ig = sigmoidf_(bv[e] + ib[e]);
      float sp = __logf(1.f + __expf(-lm[e]));
      la[e] = -8.f * r * sp;
      bb[e] = __builtin_amdgcn_sqrtf(fmaxf(1.f - __expf(2.f * la[e]), 0.f)) * ig * xr[e];
    }
    const size_t o = ((size_t)d * T + row) * 1024 + ch;
    *(uint2*)(LA + o) = pack4(la[0], la[1], la[2], la[3]);
    *(uint2*)(BV + o) = pack4(bb[0], bb[1], bb[2], bb[3]);
  }
};

template <int MODE>
DI void phase_conv(const bfr* in, int ldin, int inoff, bfr* out, int ldo, const float* cw, const float* cb) {
  constexpr int NG = MODE == 0 ? 24 : 8;
  constexpr int C = NG * 128;
  const int hw = tid_() >> 5, l31 = tid_() & 31;
  const int H = bid_() * 16 + hw;
  const int RS = (gridDim.x * 16) / NG;
  const int hd = H % NG, rl = H / NG;
  if (rl >= RS) return;
  const int c = hd * 128 + l31 * 4;
  float4 wv[4];
#pragma unroll
  for (int j = 0; j < 4; ++j) wv[j] = *(const float4*)(cw + j * C + c);
  float4 bv = make_float4(0, 0, 0, 0);
  if (MODE == 1) bv = *(const float4*)(cb + c);
  for (int r0 = rl; r0 < T; r0 += 4 * RS) {
    uint2 u[4][4];
#pragma unroll
    for (int k = 0; k < 4; ++k) {
      const int r = r0 + k * RS;
      const int b = r / LTOK, q = r - b * LTOK;
      const int lo = q < CTX ? 0 : CTX, hi = q < CTX ? CTX : LTOK;
#pragma unroll
      for (int j = 0; j < 4; ++j) {
        const int qq = q + j - 2;
        u[k][j] = make_uint2(0, 0);
        if (r < T && qq >= lo && qq < hi) u[k][j] = *(const uint2*)(in + (size_t)(b * LTOK + qq) * ldin + inoff + c);
      }
    }
#pragma unroll
    for (int k = 0; k < 4; ++k) {
      const int r = r0 + k * RS;
      float y0 = 0, y1 = 0, y2 = 0, y3 = 0;
#pragma unroll
      for (int j = 0; j < 4; ++j) {
        y0 += wv[j].x * lo2f(u[k][j].x); y1 += wv[j].y * hi2f(u[k][j].x); y2 += wv[j].z * lo2f(u[k][j].y); y3 += wv[j].w * hi2f(u[k][j].y);
      }
      if (MODE == 0) {
        y0 = siluf_(y0); y1 = siluf_(y1); y2 = siluf_(y2); y3 = siluf_(y3);
        if (hd < 16) {
          float ss = y0 * y0 + y1 * y1 + y2 * y2 + y3 * y3;
#pragma unroll
          for (int o = 16; o > 0; o >>= 1) ss += __shfl_xor(ss, o);
          float sc = rsqrtf(ss + 1e-6f);
          if (hd < 8) sc *= 0.08838834764831845f;
          y0 *= sc; y1 *= sc; y2 *= sc; y3 *= sc;
        }
      } else {
        y0 += bv.x; y1 += bv.y; y2 += bv.z; y3 += bv.w;
      }
      if (r < T) *(uint2*)(out + (size_t)r * ldo + c) = pack4(y0, y1, y2, y3);
    }
  }
}

DI int ndir_of(int cs, int d) { return d ? (cs < 4 ? 3 - cs : 135 - cs) : cs; }

DI void phase_gdn_intra(const Params& p, int j_layer, char* lds) {
  bfr* sQ = (bfr*)lds;
  bfr* sK = sQ + 64 * 136;
  float* sKK = (float*)(lds + 34816);
  float* sQK = sKK + 64 * 65;
  float* sL = sQK + 64 * 65;
  float* sgc = sL + 2 * 4096;
  float* sbt = sgc + 128;
  float* sTm = sbt + 128;
  const bfr* QKV2 = (const bfr*)p.ws;
  bfr* REC = (bfr*)(p.ws + 3 * UB);
  bfr* KT = (bfr*)(p.ws + 5 * UB);
  const float* AB = (const float*)(p.ws + OFF_AB);
  float* GC = (float*)(p.ws + OFF_GC);
  float* BT = (float*)(p.ws + OFF_BT);
  const float* a_log = p.gdn_a_log + j_layer * 16;
  const float* dtb = p.gdn_dt_bias + j_layer * 16;
  const int tid = tid_(), lane = tid & 63, w = tid >> 6, l31 = lane & 31, hh = lane >> 5;
  uint4 nq0, nq1, nk0, nk1;
#define GI_LOAD(it_)                                                                    \
  {                                                                                     \
    const int cs_ = (it_) % NCH, bh_ = (it_) / NCH;                                      \
    const bfr* g_ = QKV2 + (size_t)((bh_ >> 3) * LTOK + cs_ * 64 + (tid >> 4)) * 3072 + (bh_ & 7) * 128 + (tid & 15) * 8; \
    nq0 = *(const uint4*)g_; nk0 = *(const uint4*)(g_ + 1024);                          \
    nq1 = *(const uint4*)(g_ + (size_t)32 * 3072); nk1 = *(const uint4*)(g_ + (size_t)32 * 3072 + 1024); \
  }
  if (bid_() < NB * 8 * NCH) GI_LOAD(bid_());
  for (int item = bid_(); item < NB * 8 * NCH; item += gridDim.x) {
    const int cs = item % NCH, bh = item / NCH, h = bh & 7, b = bh >> 3;
    const int rowbase = b * LTOK + cs * 64;
    {
      const int row = tid >> 4, c8 = (tid & 15) * 8;
      *(uint4*)(sQ + row * 136 + c8) = nq0; *(uint4*)(sK + row * 136 + c8) = nk0;
      *(uint4*)(sQ + (row + 32) * 136 + c8) = nq1; *(uint4*)(sK + (row + 32) * 136 + c8) = nk1;
    }
    if (item + (int)gridDim.x < NB * 8 * NCH) GI_LOAD(item + (int)gridDim.x);
    if (w < 2) {
      const int d = w, j = lane, jj = d ? 63 - j : j;
      const float* ab = AB + (size_t)(rowbase + jj) * 32;
      float g = -__expf(a_log[d * 8 + h]) * softplusf_(ab[d * 8 + h] + dtb[d * 8 + h]);
      float bt = sigmoidf_(ab[16 + d * 8 + h]);
      float v = g;
#pragma unroll
      for (int o = 1; o < 64; o <<= 1) { float t = __shfl_up(v, o); if (lane >= o) v += t; }
      sgc[d * 64 + j] = v; sbt[d * 64 + j] = bt;
      size_t o = ((size_t)((d * 4 + b) * 8 + h)) * LTOK + ndir_of(cs, d) * 64 + j;
      GC[o] = v; BT[o] = bt;
    }
    LDS_BARRIER();
    {
      const int which = w >> 2, mt = (w >> 1) & 1, nt = w & 1;
      const bfr* Aop = which ? sQ : sK;
      f32x16 acc;
#pragma unroll
      for (int e = 0; e < 16; ++e) acc[e] = 0.f;
#pragma unroll
      for (int ks = 0; ks < 8; ++ks) {
        bf16x8 a = *(const bf16x8*)(Aop + (mt * 32 + l31) * 136 + ks * 16 + hh * 8);
        bf16x8 bb = *(const bf16x8*)(sK + (nt * 32 + l31) * 136 + ks * 16 + hh * 8);
        acc = MFMA32(a, bb, acc);
      }
      float* dst = which ? sQK : sKK;
#pragma unroll
      for (int reg = 0; reg < 16; ++reg) dst[(mt * 32 + crow(reg, hh)) * 65 + nt * 32 + l31] = acc[reg];
      bfr* kt = KT + ((size_t)(rowbase >> 6) * 8 + h) * 8192;
      int tx3 = tid; asm volatile("" : "+v"(tx3));
#pragma unroll
      for (int i = 0; i < 2; ++i) {
        int cc = tx3 + 512 * i; int dk = cc >> 3, p8 = (cc & 7) * 8;
        unsigned short v[8];
#pragma unroll
        for (int e = 0; e < 8; ++e) v[e] = sK[(p8 + e) * 136 + dk];
        *(uint4*)(kt + dk * 64 + p8) = make_uint4(v[0] | ((unsigned)v[1] << 16), v[2] | ((unsigned)v[3] << 16), v[4] | ((unsigned)v[5] << 16), v[6] | ((unsigned)v[7] << 16));
      }
    }
    LDS_BARRIER();
    int tx1 = tid; asm volatile("" : "+v"(tx1));
#pragma unroll
    for (int i = 0; i < 16; ++i) {
      int e = tx1 + 512 * i; int d = e >> 12, ii = (e >> 6) & 63, jj = e & 63;
      int si = d ? 63 - ii : ii, sj = d ? 63 - jj : jj;
      float v = 0.f;
      if (jj < ii) v = sbt[d * 64 + ii] * sKK[si * 65 + sj] * __expf(sgc[d * 64 + ii] - sgc[d * 64 + jj]);
      sL[e] = v;
    }
    LDS_BARRIER();
    if (w < 2) {
      const int d = w, c = lane;
      const float* Ld = sL + d * 4096;
      float Tc[64];
#pragma unroll
      for (int i = 0; i < 64; ++i) Tc[i] = 0.f;
#pragma unroll
      for (int i = 0; i < 64; ++i) {
        float s0 = (i == c) ? 1.f : 0.f, s1 = 0.f, s2 = 0.f, s3 = 0.f;
#pragma unroll
        for (int j4 = 0; j4 < (i + 3) / 4; ++j4) {
          float4 l = *(const float4*)(Ld + i * 64 + j4 * 4);
          s0 -= l.x * Tc[4 * j4]; s1 -= l.y * Tc[4 * j4 + 1]; s2 -= l.z * Tc[4 * j4 + 2]; s3 -= l.w * Tc[4 * j4 + 3];
        }
        Tc[i] = (s0 + s1) + (s2 + s3);
        asm volatile("" ::: "memory");
      }
      float* Td = sTm + d * 4096;
#pragma unroll
      for (int i = 0; i < 64; ++i) Td[i * 64 + c] = Tc[i];
    }
    LDS_BARRIER();
    int tx2 = tid; asm volatile("" : "+v"(tx2));
#pragma unroll
    for (int i = 0; i < 2; ++i) {
      int cc = tx2 + 512 * i; int d = cc >> 9, i_ = (cc >> 3) & 63, j8 = (cc & 7) * 8;
      bfr* rec = REC + (((size_t)((d * 4 + b) * 8 + h)) * NCH + ndir_of(cs, d)) * 8192;
      const float* Td = sTm + d * 4096 + i_ * 64 + j8;
      *(uint4*)(rec + i_ * 64 + j8) = make_uint4(pack2(Td[0], Td[1]), pack2(Td[2], Td[3]), pack2(Td[4], Td[5]), pack2(Td[6], Td[7]));
      const int si = d ? 63 - i_ : i_;
      const float gci = sgc[d * 64 + i_];
      float aq[8];
#pragma unroll
      for (int e = 0; e < 8; ++e) {
        int j = j8 + e; int sj = d ? 63 - j : j;
        float v = sQK[si * 65 + sj] * __expf(gci - sgc[d * 64 + j]);
        aq[e] = (j <= i_) ? v : 0.f;
      }
      *(uint4*)(rec + 4096 + i_ * 64 + j8) = make_uint4(pack2(aq[0], aq[1]), pack2(aq[2], aq[3]), pack2(aq[4], aq[5]), pack2(aq[6], aq[7]));
    }
    LDS_BARRIER();
  }
}

struct ScanArgs {
  const bfr* q0; const bfr* q1; int qld0, qld1;
  const bfr* k0; int kld;
  const bfr* kt0; const bfr* kt1;
  const bfr* v; int vld;
  const bfr* m;
  const float* gc; const float* bt;
  const float* dlb;
  bfr* o0; bfr* o1; int old0, old1;
};

DI uint4 rev8(uint4 u) {
  uint4 r;
  r.x = (u.w >> 16) | (u.w << 16); r.y = (u.z >> 16) | (u.z << 16); r.z = (u.y >> 16) | (u.y << 16); r.w = (u.x >> 16) | (u.x << 16);
  return r;
}

template <bool GDN>
DI void phase_scan(const ScanArgs& a, char* lds) {
  bfr* sS = (bfr*)lds;
  bfr* sKb = sS + 128 * 136;
  bfr* sQd = sKb + 64 * 136;
  bfr* sKd = sQd + 64 * 136;
  bfr* sR = sKd + 128 * 72;
  bfr* sVn = sR + 128 * 72;
  bfr* sT = sVn + 128 * 72;
  bfr* sA = sT + 64 * 72;
  float* sdl = (float*)(sA + 64 * 72);
  const int tid = tid_(), lane = tid & 63, w = tid >> 6, l31 = lane & 31, hh = lane >> 5;
  for (int item = bid_(); item < 64; item += gridDim.x) {
    const int d = item >> 5, b = (item >> 3) & 3, h = item & 7;
    const int seq = (d * 4 + b) * 8 + h;
    const bfr* qp = (d ? a.q1 + 0 : a.q0 + 0) + h * 128; const int qld = d ? a.qld1 + 0 : a.qld0 + 0;
    const bfr* kp = a.k0 + h * 128; const int kld = a.kld;
    const bfr* ktp = (d ? a.kt1 + 0 : a.kt0 + 0);
    bfr* op = (d ? a.o1 + 0 : a.o0 + 0) + h * 128; const int old = d ? a.old1 + 0 : a.old0 + 0;
    f32x16 accS[2];
#pragma unroll
    for (int t = 0; t < 2; ++t)
#pragma unroll
      for (int e = 0; e < 16; ++e) accS[t][e] = 0.f;
    for (int i = tid; i < 128 * 136 / 2; i += NTHR) ((unsigned*)sS)[i] = 0u;
    uint4 pq0, pq1, pk0, pk1, pv0, pv1, pkt0, pkt1, pm0, pm1;
    float4 pg0, pg1;
    float pgc0 = 0.f, pgc1 = 0.f, pbt0 = 0.f, pbt1 = 0.f, pgl = 0.f, pdl = 0.f;
    const int jj0 = tid >> 4, c8 = (tid & 15) * 8;
    const int dk0 = tid >> 3, p8 = (tid & 7) * 8;
#define PF1(i, n_)                                                                                              \
      {                                                                                                     \
        const int jj = jj0 + 32 * i;                                                                        \
        pq##i = *(const uint4*)(qp + (rb_ + jj) * qld + c8);                                                \
        pkt##i = *(const uint4*)(ktp + tb_ + (dk0 + 64 * i) * 64 + p8);                                     \
        if (GDN) {                                                                                          \
          pk##i = *(const uint4*)(kp + (rb_ + jj) * kld + c8);                                              \
          pv##i = *(const uint4*)(a.v + (rb_ + jj) * a.vld + h * 128 + c8);                                 \
          const int j = d ? 63 - jj : jj; pgc##i = a.gc[(size_t)seq * LTOK + (n_) * 64 + j]; pbt##i = a.bt[(size_t)seq * LTOK + (n_) * 64 + j]; \
        } else {                                                                                            \
          pv##i = *(const uint4*)(a.v + tb_ + (dk0 + 64 * i) * 64 + p8);                                    \
        }                                                                                                   \
      }
#define PREFETCH(n_)                                                                                        \
    {                                                                                                       \
      const int cs_ = ndir_of((n_), d);                                                                     \
      const size_t rb_ = (size_t)b * LTOK + cs_ * 64;                                                       \
      const size_t tb_ = ((rb_ >> 6) * 8 + h) * 8192;                                                       \
      PF1(0, n_) PF1(1, n_)                                                                                         \
      if (GDN) {                                                                                            \
        const bfr* rec_ = a.m + ((size_t)seq * NCH + (n_)) * 8192;                                          \
        pm0 = *(const uint4*)(rec_ + tid * 8); pm1 = *(const uint4*)(rec_ + 4096 + tid * 8);               \
        const float* g_ = a.gc + (size_t)seq * LTOK + (n_) * 64;                                            \
        pgl = g_[63];                                                                                       \
        const int jb_ = d ? 56 - p8 : p8;                                                                   \
        pg0 = *(const float4*)(g_ + jb_); pg1 = *(const float4*)(g_ + jb_ + 4);                             \
      } else {                                                                                              \
        pm1 = *(const uint4*)(a.m + ((size_t)seq * NCH + (n_)) * 4096 + tid * 8);                           \
        if (tid < 128) pdl = a.dlb[((size_t)seq * NCH + (n_)) * 128 + tid];                                 \
      }                                                                                                     \
    }
    PREFETCH(0);
    for (int n = 0; n < NCH; ++n) {
      const int cs = ndir_of(n, d);
      const size_t rowbase = (size_t)b * LTOK + cs * 64;
      float dl_scalar = 1.f;
      {
        int jjx = jj0; asm volatile("" : "+v"(jjx));
#define FILLA(i) {           const int jj = jjx + 32 * i; const int j = d ? 63 - jj : jj; \
          if (GDN) { \
            const float eg = __expf(pgc##i); const float qs = eg, kbs = -pbt##i * eg, vs = pbt##i; \
            unsigned uq[4] = {pq##i.x, pq##i.y, pq##i.z, pq##i.w}; \
            unsigned uk[4] = {pk##i.x, pk##i.y, pk##i.z, pk##i.w}; \
            unsigned uv[4] = {pv##i.x, pv##i.y, pv##i.z, pv##i.w}; \
            unsigned oq[4], ok[4], ov[4]; \
_Pragma("unroll") \
            for (int e = 0; e < 4; ++e) { \
              oq[e] = pack2(lo2f(uq[e]) * qs, hi2f(uq[e]) * qs); \
              ok[e] = pack2(lo2f(uk[e]) * kbs, hi2f(uk[e]) * kbs); \
              ov[e] = pack2(lo2f(uv[e]) * vs, hi2f(uv[e]) * vs); \
            } \
            *(uint4*)(sQd + j * 136 + c8) = make_uint4(oq[0], oq[1], oq[2], oq[3]); \
            *(uint4*)(sKb + j * 136 + c8) = make_uint4(ok[0], ok[1], ok[2], ok[3]); \
            *(uint4*)(sVn + j * 136 + c8) = make_uint4(ov[0], ov[1], ov[2], ov[3]); \
          } else { \
            *(uint4*)(sQd + j * 136 + c8) = pq##i; \
          } \
         }
        FILLA(0) FILLA(1)
#undef FILLA
        int dkx = dk0; asm volatile("" : "+v"(dkx));
        const int pj = d ? 56 - p8 : p8;
        float ks8[8];
        if (GDN) {
          float g8[8] = {pg0.x, pg0.y, pg0.z, pg0.w, pg1.x, pg1.y, pg1.z, pg1.w};
#pragma unroll
          for (int e = 0; e < 8; ++e) ks8[e] = __expf(pgl - g8[e]);
        }
#define FILLB(i) {           uint4 kv = d ? rev8(pkt##i) : pkt##i; \
          if (GDN) { \
            unsigned uk[4] = {kv.x, kv.y, kv.z, kv.w}; \
            kv = make_uint4(pack2(lo2f(uk[0]) * ks8[0], hi2f(uk[0]) * ks8[1]), pack2(lo2f(uk[1]) * ks8[2], hi2f(uk[1]) * ks8[3]), \
                            pack2(lo2f(uk[2]) * ks8[4], hi2f(uk[2]) * ks8[5]), pack2(lo2f(uk[3]) * ks8[6], hi2f(uk[3]) * ks8[7])); \
          } \
          *(uint4*)(sKd + (dkx + 64 * i) * 72 + pj) = kv; \
          if (!GDN) *(uint4*)(sVn + (dkx + 64 * i) * 72 + pj) = d ? rev8(pv##i) : pv##i; \
         }
        FILLB(0) FILLB(1)
#undef FILLB
        if (GDN) *(uint4*)(sT + (tid >> 3) * 72 + (tid & 7) * 8) = pm0;
        *(uint4*)(sA + (tid >> 3) * 72 + (tid & 7) * 8) = pm1;
        if (GDN) dl_scalar = __expf(pgl);
        else if (tid < 128) sdl[tid] = pdl;
      }
      if (n + 1 < NCH) PREFETCH(n + 1);
      LDS_BARRIER();
      const int mt1 = w >> 2, nt1 = w & 3;
      if (GDN) {
        f32x16 acc, acc2;
#pragma unroll
        for (int e = 0; e < 16; ++e) { acc[e] = 0.f; acc2[e] = 0.f; }
#pragma unroll
        for (int ks = 0; ks < 8; ks += 2) {
          bf16x8 af = *(const bf16x8*)(sKb + (mt1 * 32 + l31) * 136 + ks * 16 + hh * 8);
          bf16x8 bg = *(const bf16x8*)(sS + (nt1 * 32 + l31) * 136 + ks * 16 + hh * 8);
          bf16x8 af2 = *(const bf16x8*)(sKb + (mt1 * 32 + l31) * 136 + (ks + 1) * 16 + hh * 8);
          bf16x8 bg2 = *(const bf16x8*)(sS + (nt1 * 32 + l31) * 136 + (ks + 1) * 16 + hh * 8);
          acc = MFMA32(af, bg, acc);
          acc2 = MFMA32(af2, bg2, acc2);
        }
#pragma unroll
        for (int e = 0; e < 16; ++e) acc[e] += acc2[e];
#pragma unroll
        for (int g = 0; g < 4; ++g) {
          const int pos = mt1 * 32 + 8 * g + 4 * hh;
          const bfr* vp_ = sVn + pos * 136 + nt1 * 32 + l31;
          uint2 o;
          o.x = pack2(bf2f(vp_[0]) + acc[4 * g], bf2f(vp_[136]) + acc[4 * g + 1]);
          o.y = pack2(bf2f(vp_[272]) + acc[4 * g + 2], bf2f(vp_[408]) + acc[4 * g + 3]);
          *(uint2*)(sR + (nt1 * 32 + l31) * 72 + pos) = o;
        }
        LDS_BARRIER();
#pragma unroll
        for (int e = 0; e < 16; ++e) { acc[e] = 0.f; acc2[e] = 0.f; }
#pragma unroll
        for (int ks = 0; ks < 4; ks += 2) {
          bf16x8 af = *(const bf16x8*)(sT + (mt1 * 32 + l31) * 72 + ks * 16 + hh * 8);
          bf16x8 bg = *(const bf16x8*)(sR + (nt1 * 32 + l31) * 72 + ks * 16 + hh * 8);
          bf16x8 af2 = *(const bf16x8*)(sT + (mt1 * 32 + l31) * 72 + (ks + 1) * 16 + hh * 8);
          bf16x8 bg2 = *(const bf16x8*)(sR + (nt1 * 32 + l31) * 72 + (ks + 1) * 16 + hh * 8);
          acc = MFMA32(af, bg, acc);
          acc2 = MFMA32(af2, bg2, acc2);
        }
#pragma unroll
        for (int e = 0; e < 16; ++e) acc[e] += acc2[e];
#pragma unroll
        for (int g = 0; g < 4; ++g) {
          uint2 o; o.x = pack2(acc[4 * g], acc[4 * g + 1]); o.y = pack2(acc[4 * g + 2], acc[4 * g + 3]);
          *(uint2*)(sVn + (nt1 * 32 + l31) * 72 + mt1 * 32 + 8 * g + 4 * hh) = o;
        }
        LDS_BARRIER();
      }
      {
        f32x16 acc, acc2, acc3;
#pragma unroll
        for (int e = 0; e < 16; ++e) { acc[e] = 0.f; acc2[e] = 0.f; acc3[e] = 0.f; }
#pragma unroll
        for (int ks = 0; ks < 4; ++ks) {
          bf16x8 af = *(const bf16x8*)(sQd + (mt1 * 32 + l31) * 136 + ks * 16 + hh * 8);
          bf16x8 bg = *(const bf16x8*)(sS + (nt1 * 32 + l31) * 136 + ks * 16 + hh * 8);
          bf16x8 af2 = *(const bf16x8*)(sQd + (mt1 * 32 + l31) * 136 + (ks + 4) * 16 + hh * 8);
          bf16x8 bg2 = *(const bf16x8*)(sS + (nt1 * 32 + l31) * 136 + (ks + 4) * 16 + hh * 8);
          bf16x8 af3 = *(const bf16x8*)(sA + (mt1 * 32 + l31) * 72 + ks * 16 + hh * 8);
          bf16x8 bg3 = *(const bf16x8*)(sVn + (nt1 * 32 + l31) * 72 + ks * 16 + hh * 8);
          acc = MFMA32(af, bg, acc);
          acc2 = MFMA32(af2, bg2, acc2);
          acc3 = MFMA32(af3, bg3, acc3);
        }
#pragma unroll
        for (int e = 0; e < 16; ++e) acc[e] += acc2[e] + acc3[e];
#pragma unroll
        for (int reg = 0; reg < 16; ++reg) sR[(mt1 * 32 + crow(reg, hh)) * 136 + nt1 * 32 + l31] = f2bf(acc[reg]);
      }
      {
        const int mt = w >> 1;
#pragma unroll
        for (int t = 0; t < 2; ++t)
#pragma unroll
          for (int reg = 0; reg < 16; ++reg) {
            float dl = GDN ? dl_scalar : sdl[mt * 32 + crow(reg, hh)];
            accS[t][reg] *= dl;
          }
#pragma unroll
        for (int ks = 0; ks < 4; ++ks) {
          bf16x8 af = *(const bf16x8*)(sKd + (mt * 32 + l31) * 72 + ks * 16 + hh * 8);
          bf16x8 bg0 = *(const bf16x8*)(sVn + ((2 * (w & 1)) * 32 + l31) * 72 + ks * 16 + hh * 8);
          bf16x8 bg1 = *(const bf16x8*)(sVn + ((2 * (w & 1) + 1) * 32 + l31) * 72 + ks * 16 + hh * 8);
          accS[0] = MFMA32(af, bg0, accS[0]);
          accS[1] = MFMA32(af, bg1, accS[1]);
        }
        LDS_BARRIER();
#pragma unroll
        for (int t = 0; t < 2; ++t) {
          const int nt = 2 * (w & 1) + t;
#pragma unroll
          for (int g = 0; g < 4; ++g) {
            uint2 o; o.x = pack2(accS[t][4 * g], accS[t][4 * g + 1]); o.y = pack2(accS[t][4 * g + 2], accS[t][4 * g + 3]);
            *(uint2*)(sS + (nt * 32 + l31) * 136 + mt * 32 + 8 * g + 4 * hh) = o;
          }
        }
        {
          int tx = tid; asm volatile("" : "+v"(tx));
#pragma unroll
          for (int i = 0; i < 2; ++i) {
            const int j = (tx >> 4) + 32 * i, c8o = (tx & 15) * 8;
            const uint4 ov = *(const uint4*)(sR + j * 136 + c8o);
            if (GDN) *(uint4*)((bfr*)a.m + ((size_t)seq * NCH + n) * 8192 + j * 128 + c8o) = ov;
            else { const int jj = d ? 63 - j : j; *(uint4*)(op + (rowbase + jj) * old + c8o) = ov; }
          }
        }
        if (GDN) asm volatile("" : "+v"(pgl), "+v"(pgc0), "+v"(pgc1), "+v"(pbt0), "+v"(pbt1), "+v"(pg0.x), "+v"(pg0.y), "+v"(pg0.z), "+v"(pg0.w), "+v"(pg1.x), "+v"(pg1.y), "+v"(pg1.z), "+v"(pg1.w));
        else asm volatile("" : "+v"(pdl));
      }
    }
#undef PREFETCH
#undef PF1
    LDS_BARRIER();
  }
}

template <bool REC>
DI void phase_headnorm(const bfr* of, const bfr* ob, const bfr* z, const float* nw, bfr* Y) {
  const int lane = tid_() & 63, w = tid_() >> 6;
  const int c = lane * 16;
  float wv[16];
#pragma unroll
  for (int e = 0; e < 16; ++e) wv[e] = nw[(c + e) & 127];
  const int stride = gridDim.x * 8;
  for (int r0 = bid_() * 8 + w; r0 < T; r0 += 2 * stride) {
    uint4 f0[2], f1[2], b0[2], b1[2], z0[2], z1[2];
#pragma unroll
    for (int k = 0; k < 2; ++k) {
      const int r = r0 + k * stride < T ? r0 + k * stride : r0;
      const bfr *pf, *pb;
      if (REC) {
        const int b = r / LTOK, q = r - b * LTOK, cs = q >> 6, jj = q & 63, h = lane >> 3;
        pf = of + (((size_t)(b * 8 + h)) * NCH + cs) * 8192 + jj * 128 + (c & 127);
        pb = of + (((size_t)((4 + b) * 8 + h)) * NCH + ndir_of(cs, 1)) * 8192 + (63 - jj) * 128 + (c & 127);
      } else {
        pf = of + (size_t)r * 1024 + c; pb = ob + (size_t)r * 1024 + c;
      }
      f0[k] = *(const uint4*)pf; f1[k] = *(const uint4*)(pf + 8);
      b0[k] = *(const uint4*)pb; b1[k] = *(const uint4*)(pb + 8);
      z0[k] = *(const uint4*)(z + (size_t)r * 1024 + c); z1[k] = *(const uint4*)(z + (size_t)r * 1024 + c + 8);
    }
#pragma unroll
    for (int k = 0; k < 2; ++k) {
      const int r = r0 + k * stride;
      unsigned fu[8] = {f0[k].x, f0[k].y, f0[k].z, f0[k].w, f1[k].x, f1[k].y, f1[k].z, f1[k].w};
      unsigned bu[8] = {b0[k].x, b0[k].y, b0[k].z, b0[k].w, b1[k].x, b1[k].y, b1[k].z, b1[k].w};
      unsigned zu[8] = {z0[k].x, z0[k].y, z0[k].z, z0[k].w, z1[k].x, z1[k].y, z1[k].z, z1[k].w};
      float o[16]; float ss = 0;
#pragma unroll
      for (int e = 0; e < 8; ++e) {
        o[2 * e] = lo2f(fu[e]) + lo2f(bu[e]); o[2 * e + 1] = hi2f(fu[e]) + hi2f(bu[e]);
        ss += o[2 * e] * o[2 * e] + o[2 * e + 1] * o[2 * e + 1];
      }
      ss += __shfl_xor(ss, 1); ss += __shfl_xor(ss, 2); ss += __shfl_xor(ss, 4);
      float rstd = rsqrtf(ss * (1.f / 128.f) + 1e-6f);
      unsigned ou[8];
#pragma unroll
      for (int e = 0; e < 8; ++e) {
        float y0 = o[2 * e] * rstd * wv[2 * e] * siluf_(lo2f(zu[e]));
        float y1 = o[2 * e + 1] * rstd * wv[2 * e + 1] * siluf_(hi2f(zu[e]));
        ou[e] = pack2(y0, y1);
      }
      if (r < T) {
        *(uint4*)(Y + (size_t)r * 1024 + c) = make_uint4(ou[0], ou[1], ou[2], ou[3]);
        *(uint4*)(Y + (size_t)r * 1024 + c + 8) = make_uint4(ou[4], ou[5], ou[6], ou[7]);
      }
    }
  }
}

DI int lru_row(int b, int d, int u) { int q = (u < CTX) ? (d ? CTX - 1 - u : u) : (d ? (LTOK - 1 + CTX) - u : u); return b * LTOK + q; }

DI void phase_lru_scan(const bfr* LA, bfr* BV, char* lds) {
  float* sSeg = (float*)lds;
  const int lane = tid_() & 63, w = tid_() >> 6;
  const int seg = w * 2 + (lane >> 5), cl = lane & 31;
  constexpr int SEGL = LTOK / 16;
  constexpr int BS = 16;
  for (int item = bid_(); item < NB * 2 * 32; item += gridDim.x) {
    const int cg_ = item & 31, d = (item >> 5) & 1, b = item >> 6;
    const int ch = cg_ * 32 + cl;
    const size_t base = (size_t)d * T * 1024 + ch;
    float h = 0.f, sl = 0.f;
    for (int u0 = seg * SEGL; u0 < (seg + 1) * SEGL; u0 += BS) {
      const long o0 = (long)base + (long)lru_row(b, d, u0) * 1024;
      const long st = d ? -1024 : 1024;
      bfr la[BS], bv[BS];
#pragma unroll
      for (int e = 0; e < BS; ++e) { la[e] = LA[o0 + e * st]; bv[e] = BV[o0 + e * st]; }
#pragma unroll
      for (int e = 0; e < BS; ++e) { float l = bf2f(la[e]); h = __expf(l) * h + bf2f(bv[e]); sl += l; }
    }
    sSeg[(seg * 2) * 32 + cl] = sl; sSeg[(seg * 2 + 1) * 32 + cl] = h;
    LDS_BARRIER();
    float h0 = 0.f;
    for (int s_ = 0; s_ < seg; ++s_) h0 = __expf(sSeg[(s_ * 2) * 32 + cl]) * h0 + sSeg[(s_ * 2 + 1) * 32 + cl];
    h = h0;
    for (int u0 = seg * SEGL; u0 < (seg + 1) * SEGL; u0 += BS) {
      const long o0 = (long)base + (long)lru_row(b, d, u0) * 1024;
      const long st = d ? -1024 : 1024;
      bfr la[BS], bv[BS];
#pragma unroll
      for (int e = 0; e < BS; ++e) { la[e] = LA[o0 + e * st]; bv[e] = BV[o0 + e * st]; }
#pragma unroll
      for (int e = 0; e < BS; ++e) { h = __expf(bf2f(la[e])) * h + bf2f(bv[e]); bv[e] = f2bf(h); }
#pragma unroll
      for (int e = 0; e < BS; ++e) BV[o0 + e * st] = bv[e];
    }
    LDS_BARRIER();
  }
}

DI void phase_lru_combine(const bfr* P, const bfr* BV, bfr* Y) {
  const size_t total = (size_t)T * 128;
  for (size_t i = (size_t)bid_() * NTHR + tid_(); i < total; i += (size_t)gridDim.x * NTHR) {
    size_t r = i >> 7; int c = (int)(i & 127) * 8;
    uint4 g = *(const uint4*)(P + r * 2048 + c);
    uint4 f = *(const uint4*)(BV + r * 1024 + c);
    uint4 bk = *(const uint4*)(BV + ((size_t)T + r) * 1024 + c);
    unsigned gu[4] = {g.x, g.y, g.z, g.w}, fu[4] = {f.x, f.y, f.z, f.w}, bu[4] = {bk.x, bk.y, bk.z, bk.w}, ou[4];
#pragma unroll
    for (int e = 0; e < 4; ++e) {
      float y0 = geluf_(lo2f(gu[e])) * (lo2f(fu[e]) + lo2f(bu[e]));
      float y1 = geluf_(hi2f(gu[e])) * (hi2f(fu[e]) + hi2f(bu[e]));
      ou[e] = pack2(y0, y1);
    }
    *(uint4*)(Y + r * 1024 + c) = make_uint4(ou[0], ou[1], ou[2], ou[3]);
  }
}

template <int D_, int H_>
DI void hg_column(uint4* fr, const float lb, const bfr* sQs, bfr* sQe, bfr* sKe, bfr* qdst, int qdld, int c, float* sx, float& dl_out) {
  float lf[32];
  float sum = 0.f;
#pragma unroll
  for (int jl = 0; jl < 32; ++jl) {
    const int q = D_ ? 31 - jl : jl;
    const unsigned u = ((const unsigned*)fr)[q >> 1];
    const float raw = (q & 1) ? hi2f(u) : lo2f(u);
    const float f = lb + (1.f - lb) * sigmoidf_(raw);
    lf[jl] = __logf(f);
    sum += lf[jl];
  }
  sx[H_ * 2] = sum; sx[H_ * 2 + 1] = lf[0];
  LDS_BARRIER();
  const float sum0 = sx[0], sum1 = sx[2], lf32 = sx[3];
  const float glast = sum0 + sum1, ref = sum0 + lf32;
  float gc = H_ ? sum0 : 0.f;
  unsigned short kd[32];
#pragma unroll
  for (int jl = 0; jl < 32; ++jl) {
    const int j = 32 * H_ + jl, jj = D_ ? 63 - j : j, q = D_ ? 31 - jl : jl;
    gc += lf[jl];
    const float kf = 1.f - __expf(lf[jl]);
    const float qs = bf2f(sQs[jj * 128 + c]);
    sQe[(D_ * 64 + j) * 136 + c] = f2bf(qs * __expf(gc - ref));
    sKe[(D_ * 64 + j) * 136 + c] = f2bf(kf * __expf(ref - gc));
    kd[q] = f2bf(kf * __expf(glast - gc));
    qdst[(size_t)jj * qdld] = f2bf(qs * __expf(gc));
  }
#pragma unroll
  for (int i = 0; i < 4; ++i)
    fr[i] = make_uint4(kd[8 * i] | ((unsigned)kd[8 * i + 1] << 16), kd[8 * i + 2] | ((unsigned)kd[8 * i + 3] << 16),
                       kd[8 * i + 4] | ((unsigned)kd[8 * i + 5] << 16), kd[8 * i + 6] | ((unsigned)kd[8 * i + 7] << 16));
  dl_out = __expf(glast);
}

DI void phase_hg_intra(const Params& p, int layer, char* lds) {
  bfr* sQe = (bfr*)lds;
  bfr* sKe = sQe + 2 * 64 * 136;
  bfr* sQs = sKe + 2 * 64 * 136;
  float* sXc = (float*)(sQs + 64 * 128);
  bfr* Q = (bfr*)(p.ws + UB);
  bfr* QD1 = (bfr*)p.ws;
  bfr* SC = (bfr*)(p.ws + 6 * UB);
  float* DLB = (float*)(p.ws + OFF_AB);
  const int tid = tid_(), lane = tid & 63, w = tid >> 6, l31 = lane & 31, hh = lane >> 5;
  for (int item = bid_(); item < NB * 8 * NCH; item += gridDim.x) {
    const int cs = item % NCH, bh = item / NCH, h = bh & 7, b = bh >> 3;
    const size_t rowbase = (size_t)b * LTOK + cs * 64;
#pragma unroll
    for (int i = 0; i < 2; ++i) {
      int cc = tid + 512 * i; int row = cc >> 4, c8 = (cc & 15) * 8;
      uint4 u = *(const uint4*)(Q + (rowbase + row) * 1024 + h * 128 + c8);
      unsigned uu[4] = {u.x, u.y, u.z, u.w}, oo[4];
#pragma unroll
      for (int e = 0; e < 4; ++e) oo[e] = pack2(siluf_(lo2f(uu[e])), siluf_(hi2f(uu[e])));
      *(uint4*)(sQs + row * 128 + c8) = make_uint4(oo[0], oo[1], oo[2], oo[3]);
    }
    LDS_BARRIER();
    {
      const int d = (tid >> 7) & 1, c = tid & 127, hf = tid >> 8, hc = h * 128 + c;
      float x0 = p.hg_lb_logits[hc], x1 = p.hg_lb_logits[1024 + hc], x2 = p.hg_lb_logits[2048 + hc], x3 = p.hg_lb_logits[3072 + hc];
      float mx = fmaxf(fmaxf(x0, x1), fmaxf(x2, x3));
      float e0 = expf(x0 - mx), e1 = expf(x1 - mx), e2 = expf(x2 - mx), e3 = expf(x3 - mx);
      float inv = 1.f / (e0 + e1 + e2 + e3);
      float lb = 0.f;
      if (layer >= 1) lb += e1 * inv;
      if (layer >= 2) lb += e2 * inv;
      if (layer >= 3) lb += e3 * inv;
      const int sh = d ? 1 - hf : hf;
      bfr* fcol = (bfr*)(p.ws + (size_t)(2 + d) * UB) + (((rowbase >> 6) * 8 + h) * 8192) + c * 64 + 32 * sh;
      uint4 fr[4];
#pragma unroll
      for (int i = 0; i < 4; ++i) fr[i] = *(const uint4*)(fcol + 8 * i);
      float* sx = sXc + (d * 128 + c) * 4;
      float dl;
      bfr* q0 = Q + rowbase * 1024 + hc; bfr* q1 = QD1 + rowbase * 1024 + hc;
      if (d == 0) { if (hf == 0) hg_column<0, 0>(fr, lb, sQs, sQe, sKe, q0, 1024, c, sx, dl); else hg_column<0, 1>(fr, lb, sQs, sQe, sKe, q0, 1024, c, sx, dl); }
      else { if (hf == 0) hg_column<1, 0>(fr, lb, sQs, sQe, sKe, q1, 1024, c, sx, dl); else hg_column<1, 1>(fr, lb, sQs, sQe, sKe, q1, 1024, c, sx, dl); }
#pragma unroll
      for (int i = 0; i < 4; ++i) *(uint4*)(fcol + 8 * i) = fr[i];
      if (hf == 0) {
        const int seq = (d * 4 + b) * 8 + h;
        DLB[((size_t)seq * NCH + ndir_of(cs, d)) * 128 + c] = dl;
      }
    }
    LDS_BARRIER();
    {
      const int d = w >> 2, mt = (w >> 1) & 1, nt = w & 1;
      f32x16 acc;
#pragma unroll
      for (int e = 0; e < 16; ++e) acc[e] = 0.f;
#pragma unroll
      for (int ks = 0; ks < 8; ++ks) {
        bf16x8 af = *(const bf16x8*)(sQe + (d * 64 + mt * 32 + l31) * 136 + ks * 16 + hh * 8);
        bf16x8 bg = *(const bf16x8*)(sKe + (d * 64 + nt * 32 + l31) * 136 + ks * 16 + hh * 8);
        acc = MFMA32(af, bg, acc);
      }
      const int seq = (d * 4 + b) * 8 + h;
      bfr* dst = SC + ((size_t)seq * NCH + ndir_of(cs, d)) * 4096;
#pragma unroll
      for (int reg = 0; reg < 16; ++reg) {
        int i_ = mt * 32 + crow(reg, hh), j_ = nt * 32 + l31;
        dst[i_ * 64 + j_] = (j_ <= i_) ? f2bf(acc[reg]) : (bfr)0;
      }
    }
    LDS_BARRIER();
  }
}

DI void phase_final(const Params& p) {
  const int lane = tid_() & 63, w = tid_() >> 6;
  const int stride = gridDim.x * 8;
  float4 wv[4];
#pragma unroll
  for (int i = 0; i < 4; ++i) wv[i] = *(const float4*)(p.norm_final + lane * 4 + 256 * i);
  for (int r0 = bid_() * 8 + w; r0 < NB * SEQ; r0 += 4 * stride) {
    float4 v[4][4];
#pragma unroll
    for (int k = 0; k < 4; ++k)
#pragma unroll
      for (int i = 0; i < 4; ++i) v[k][i] = *(const float4*)(p.out + (size_t)(r0 + k * stride) * DM + lane * 4 + 256 * i);
#pragma unroll
    for (int k = 0; k < 4; ++k) {
      float ss = 0;
#pragma unroll
      for (int i = 0; i < 4; ++i) ss += v[k][i].x * v[k][i].x + v[k][i].y * v[k][i].y + v[k][i].z * v[k][i].z + v[k][i].w * v[k][i].w;
#pragma unroll
      for (int o = 32; o > 0; o >>= 1) ss += __shfl_xor(ss, o);
      const float rstd = rsqrtf(ss * (1.f / 1024.f) + 1e-6f);
#pragma unroll
      for (int i = 0; i < 4; ++i) {
        float4 o; o.x = v[k][i].x * rstd * wv[i].x; o.y = v[k][i].y * rstd * wv[i].y; o.z = v[k][i].z * rstd * wv[i].z; o.w = v[k][i].w * rstd * wv[i].w;
        *(float4*)(p.out + (size_t)(r0 + k * stride) * DM + lane * 4 + 256 * i) = o;
      }
    }
  }
}

#define XB_TMO      128
#define XB_XCNT(j)  (256  + 64 * (j))
#define XB_XSUB(j)  (1280 + 64 * (j))
#define XB_XGEN(j)  (2304 + 64 * (j))
#define XB_TOP      3328
#define XB_TOPGEN   3392
#define XCD_BAR_WORDS 3456
#define XB_SPIN_CAP (1u << 18)
#define LAS __attribute__((address_space(3)))

__device__ __forceinline__ unsigned xb_ld(unsigned* p)              { return __hip_atomic_load(p, __ATOMIC_RELAXED, __HIP_MEMORY_SCOPE_AGENT); }
__device__ __forceinline__ unsigned xb_add(unsigned* p, unsigned v) { return __hip_atomic_fetch_add(p, v, __ATOMIC_RELAXED, __HIP_MEMORY_SCOPE_AGENT); }
__device__ __forceinline__ unsigned xb_xcc_id() { return (unsigned)__builtin_amdgcn_s_getreg((3 << 11) | 20) & 0xFu; }
#define XB_SPIN(cond, bar) do { unsigned _sp = 0; while (cond) { __builtin_amdgcn_s_sleep(1); \
    if ((++_sp & 255u) == 0u) { if (xb_ld(&(bar)[XB_TMO])) break; if (_sp > XB_SPIN_CAP) { atomicAdd(&(bar)[XB_TMO], 1u); break; } } } } while (0)

struct XcdBarrier {
    unsigned* bar; unsigned x;
    volatile LAS unsigned* st;
};

__device__ __forceinline__ XcdBarrier xcd_barrier_post(unsigned* bar, volatile LAS unsigned* st) {
    XcdBarrier b; b.bar = bar; b.x = xb_xcc_id(); b.st = st;
    if (threadIdx.x == 0) (void)xb_add(&bar[XB_XCNT(b.x)], 1u);
    return b;
}
__device__ __forceinline__ void xcd_barrier_complete(unsigned* bar, unsigned x, unsigned& nloc, unsigned& nx) {
    const unsigned G = gridDim.x * gridDim.y * gridDim.z;
    unsigned sum, cnt, mine, sp = 0u;
    for (;;) {
        sum = 0u; cnt = 0u; mine = 0u;
#pragma unroll
        for (unsigned j = 0; j < 16; ++j) { const unsigned c = xb_ld(&bar[XB_XCNT(j)]); sum += c; cnt += (c > 0u) ? 1u : 0u; mine = (j == x) ? c : mine; }
        if (sum == G) break;
        __builtin_amdgcn_s_sleep(1);
        if ((++sp & 255u) == 0u) { if (xb_ld(&bar[XB_TMO])) break; if (sp > XB_SPIN_CAP) { atomicAdd(&bar[XB_TMO], 1u); break; } }
    }
    nloc = mine > 0u ? mine : 1u; nx = cnt > 0u ? cnt : 1u;
}

__device__ __forceinline__ void xcd_barrier(const XcdBarrier& b) {
    asm volatile("s_waitcnt vmcnt(0)" ::: "memory");
    __syncthreads();
    if (threadIdx.x == 0) {
        unsigned* bar = b.bar;
        __builtin_amdgcn_s_waitcnt(0);
        unsigned nloc = b.st[0], nx = b.st[1];
        const unsigned old = xb_add(&bar[XB_XSUB(b.x)], 1u);
        const unsigned gen = old / nloc;
        if (old + 1u == (gen + 1u) * nloc) {
            __builtin_amdgcn_fence(__ATOMIC_RELEASE, "agent");
            asm volatile("s_waitcnt vmcnt(0)" ::: "memory");
            const unsigned og = xb_add(&bar[XB_TOP], 1u);
            const unsigned tg = og / nx;
            if (og + 1u == (tg + 1u) * nx) xb_add(&bar[XB_TOPGEN], 1u);
            else XB_SPIN(xb_ld(&bar[XB_TOPGEN]) == tg, bar);
            __builtin_amdgcn_fence(__ATOMIC_ACQUIRE, "agent");
            xb_add(&bar[XB_XGEN(b.x)], 1u);
            asm volatile("s_waitcnt vmcnt(0)" ::: "memory");
        } else {
            XB_SPIN(xb_ld(&bar[XB_XGEN(b.x)]) == gen, bar);
            __builtin_amdgcn_fence(__ATOMIC_ACQUIRE, "agent");
            asm volatile("s_waitcnt vmcnt(0)" ::: "memory");
        }
    }
    __syncthreads();
}


__global__ void __launch_bounds__(NTHR) fwd_megakernel(Params p) {
  extern __shared__ __attribute__((aligned(16))) char lds[];
  cg::grid_group grid = cg::this_grid();
  volatile LAS unsigned* xst = (volatile LAS unsigned*)(lds + 147456 + 256);
  if (threadIdx.x == 0) { xst[0] = 0u; xst[1] = 0u; xst[2] = 0u; xst[3] = 0u; }
  __syncthreads();
  (void)xcd_barrier_post((unsigned*)(p.ws + OFF_BAR), xst);
  int ph = 0;
  const int lo = p.ph_lo, hi = p.ph_hi;
#define PHASE(...) { if (ph >= lo && ph < hi) { __VA_ARGS__; if (ph + 1 < hi) { XcdBarrier xb_; xb_.bar = (unsigned*)(p.ws + OFF_BAR); xb_.x = xb_xcc_id(); xb_.st = (volatile LAS unsigned*)(lds + 147456 + 256); xcd_barrier(xb_); } } ++ph; }
  const float* MODB = (const float*)(p.ws + OFF_MOD);
  bfr* H = (bfr*)p.ws;
  const bfr* WB = (const bfr*)(p.ws + OFF_WB);
  { phase_mod(p, lds); grid.sync(); if (threadIdx.x == 0) { unsigned nl_, nx_; xcd_barrier_complete((unsigned*)(p.ws + OFF_BAR), xb_xcc_id(), nl_, nx_); xst[0] = nl_; xst[1] = nx_; } __syncthreads(); ++ph; }
#pragma unroll 1
  for (int layer = 0; layer < 4; ++layer) {
    const bool colmaj = (layer & 1) != 0;
    const bool first = layer == 0;
    const bool last = layer == 3;
    const int kind = layer % 3, jl = layer / 3;
    const float* MODL = MODB + (size_t)layer * 5 * 6144;
    PHASE({ phase_norm(p, layer, p.norm_mix + layer * 1024, 0, 1, colmaj, first); phase_wprep(p, layer, lds, first ? 7 : 2, bid_(), gridDim.x); });
    if (kind == 0) {
      PHASE({ EpiGdnIn e{WB + WB_IN, (bfr*)(p.ws + 3 * UB), (bfr*)(p.ws + 6 * UB), (float*)(p.ws + OFF_AB)};
              gemm_phase_glds16(H, 17, e, lds); });
      PHASE(phase_conv<0>((const bfr*)(p.ws + 3 * UB), 3072, 0, (bfr*)p.ws, 3072, p.gdn_conv + (size_t)jl * 4 * 3072, nullptr));
      PHASE(phase_gdn_intra(p, jl, lds));
      PHASE({ ScanArgs a;
              a.q0 = a.q1 = (const bfr*)p.ws; a.qld0 = a.qld1 = 3072;
              a.k0 = (const bfr*)p.ws + 1024; a.kld = 3072;
              a.kt0 = a.kt1 = (const bfr*)(p.ws + 5 * UB);
              a.v = (const bfr*)p.ws + 2048; a.vld = 3072;
              a.m = (const bfr*)(p.ws + 3 * UB); a.gc = (const float*)(p.ws + OFF_GC); a.bt = (const float*)(p.ws + OFF_BT); a.dlb = nullptr;
              a.o0 = a.o1 = nullptr; a.old0 = a.old1 = 0;
              phase_scan<true>(a, lds); });
      PHASE(phase_headnorm<true>((const bfr*)(p.ws + 3 * UB), nullptr, (const bfr*)(p.ws + 6 * UB), p.gdn_norm + jl * 128, (bfr*)p.ws));
      PHASE({ EpiResid e{WB + WB_OUT, &p, MODL + 2 * 1024, colmaj, first, 1024};
              gemm_phase_glds16((const bfr*)p.ws, 4, e, lds, 1024, 128, last); if (!last) gemm_phase<128>((const bfr*)p.ws, 1024, 1024, 8, e, lds, 256, 8); });
    } else if (kind == 1) {
      PHASE({ EpiPlain e{WB + WB_IN, (bfr*)(p.ws + UB), 2048, 1024};
              gemm_phase_glds16(H, 8, e, lds); });
      PHASE(phase_conv<1>((const bfr*)(p.ws + UB), 2048, 1024, (bfr*)p.ws, 1024, p.lru_conv_w + (size_t)jl * 4 * 1024, p.lru_conv_b + jl * 1024));
      PHASE({ EpiLruGate e{WB + WB_GATE, p.lru_b_r + jl * 2048, p.lru_b_i + jl * 2048,
                           p.lru_lambda + jl * 2048, (const bfr*)p.ws, (bfr*)(p.ws + 3 * UB), (bfr*)(p.ws + 5 * UB)};
              gemm_phase<256>((const bfr*)p.ws, 1024, 128, 32, e, lds); });
      PHASE(phase_lru_scan((const bfr*)(p.ws + 3 * UB), (bfr*)(p.ws + 5 * UB), lds));
      PHASE(phase_lru_combine((const bfr*)(p.ws + UB), (const bfr*)(p.ws + 5 * UB), (bfr*)p.ws));
      PHASE({ EpiResid e{WB + WB_OUT, &p, MODL + 2 * 1024, colmaj, first, 1024};
              gemm_phase_glds16((const bfr*)p.ws, 4, e, lds, 1024, 128, last); if (!last) gemm_phase<128>((const bfr*)p.ws, 1024, 1024, 8, e, lds, 256, 8); });
    } else {
      PHASE({ EpiHgIn e{WB + WB_IN, p.ws};
              gemm_phase_glds16(H, 20, e, lds); });
      PHASE(phase_hg_intra(p, layer, lds));
      PHASE({ ScanArgs a;
              a.q0 = (const bfr*)(p.ws + UB); a.q1 = (const bfr*)p.ws; a.qld0 = a.qld1 = 1024;
              a.k0 = nullptr; a.kld = 0;
              a.kt0 = (const bfr*)(p.ws + 2 * UB); a.kt1 = (const bfr*)(p.ws + 3 * UB);
              a.v = (const bfr*)(p.ws + 4 * UB); a.vld = 0;
              a.m = (const bfr*)(p.ws + 6 * UB); a.gc = nullptr; a.bt = nullptr; a.dlb = (const float*)(p.ws + OFF_AB);
              a.o0 = (bfr*)(p.ws + UB); a.o1 = (bfr*)p.ws; a.old0 = a.old1 = 1024;
              phase_scan<false>(a, lds); });
      PHASE(phase_headnorm<false>((const bfr*)(p.ws + UB), (const bfr*)p.ws, (const bfr*)(p.ws + 5 * UB), p.hg_norm + jl * 128, (bfr*)(p.ws + 6 * UB)));
      PHASE({ EpiResid e{WB + WB_OUT, &p, MODL + 2 * 1024, colmaj, first, 1024};
              gemm_phase_glds16((const bfr*)(p.ws + 6 * UB), 4, e, lds, 1024, 128, last); if (!last) gemm_phase<128>((const bfr*)(p.ws + 6 * UB), 1024, 1024, 8, e, lds, 256, 8); });
    }
    PHASE(phase_norm(p, layer, p.norm_ffn + layer * 1024, 3, 4, false, false));
    PHASE({ EpiFfnUp e{WB + WB_W1, (bfr*)(p.ws + UB)};
            gemm_phase_glds16(H, 22, e, lds, 1024, last ? 128 : 132, last); });
    PHASE({ EpiResid e{WB + WB_W2, &p, MODL + 5 * 1024, false, false, FFH};
            gemm_phase_glds16((const bfr*)(p.ws + UB), 4, e, lds, FFH, 128, last); if (!last) gemm_phase<128>((const bfr*)(p.ws + UB), FFH, FFH, 8, e, lds, 256, 8);
            if (!last) { const int b7 = bid_() & 7; phase_wprep(p, layer + 1, lds, 5, b7 >= 2 ? (bid_() >> 3) * 6 + (b7 - 2) : -1, (gridDim.x >> 3) * 6); } });
  }
  PHASE(phase_final(p));
#undef PHASE
}

constexpr int N_PHASES = 1 + 10 + 10 + 9 + 10 + 1;

extern "C" void kernel_launch(void* const* d_in, const int* in_sizes, int n_in, void* d_out, int out_size, void* d_ws,
                              size_t ws_size, hipStream_t stream) {
  static int grid_blocks = 0;
  if (!grid_blocks) {
    if (ws_size < WS_NEED) { fprintf(stderr, "kernel_launch: workspace too small: %zu < %zu\n", ws_size, (size_t)WS_NEED); grid_blocks = -1; return; }
    int dev = 0, cus = 0, per_cu = 0;
    hipGetDevice(&dev);
    hipDeviceGetAttribute(&cus, hipDeviceAttributeMultiprocessorCount, dev);
    if (hipFuncSetAttribute((const void*)fwd_megakernel, hipFuncAttributeMaxDynamicSharedMemorySize, LDS_BYTES) != hipSuccess) {
      fprintf(stderr, "kernel_launch: hipFuncSetAttribute failed\n"); grid_blocks = -1; return;
    }
    hipOccupancyMaxActiveBlocksPerMultiprocessor(&per_cu, (const void*)fwd_megakernel, NTHR, LDS_BYTES);
    if (per_cu < 1) { fprintf(stderr, "kernel_launch: occupancy query gave %d\n", per_cu); per_cu = 1; }
    if (per_cu > 1) per_cu = 1;
    grid_blocks = cus * per_cu;
    (void)hipGetLastError();
  }
  if (grid_blocks < 0) return;
  Params p{};
  const float** fp = (const float**)&p;
  for (int i = 0; i < 31; ++i) fp[i] = (const float*)d_in[i];
  p.out = (float*)d_out;
  p.ws = (char*)d_ws;
  hipMemsetAsync((char*)d_ws + OFF_BAR, 0, BAR_BYTES, stream);
#if MULTI_LAUNCH
  for (int ph = 0; ph < N_PHASES; ++ph) {
    p.ph_lo = ph; p.ph_hi = ph + 1;
    hipLaunchKernelGGL(fwd_megakernel, dim3(grid_blocks), dim3(NTHR), LDS_BYTES, stream, p);
  }
#else
  p.ph_lo = 0; p.ph_hi = N_PHASES;
  void* args[] = {&p};
  hipError_t e = hipLaunchCooperativeKernel((const void*)fwd_megakernel, dim3(grid_blocks), dim3(NTHR), args, LDS_BYTES, stream);
  if (e != hipSuccess) fprintf(stderr, "cooperative launch failed: %s (grid %d)\n", hipGetErrorString(e), grid_blocks);
#endif
}
```
